# Optimizing an MI355X kernel written in HIP

```python
import jax, jax.numpy as jnp
from jax import lax
import numpy as np

D_MODEL = 1024
BATCH = 2
SEQ = 8192
DEPTH = 4

MLA_HEADS = 8
MLA_NOPE = 64
MLA_ROPE = 32
MLA_V = 64
Q_LORA = 384
KV_LORA = 256
MLA_WIDTH = MLA_HEADS * MLA_V

DIL_PAIRS = ((128, 1), (512, 4), (2048, 16))
DIL_GROUPS = 3
DIL_HEADS = 8
DIL_HD = 64
DIL_WIDTH = DIL_HEADS * DIL_HD
ROT_DIM = DIL_HD // 4

MIX_WIDTH = MLA_WIDTH + DIL_WIDTH
ROPE_THETA = 500000.0
Q_BLOCK = 128
EPS = 1e-6

IN_SPLITS = (Q_LORA, KV_LORA, MLA_ROPE, MLA_WIDTH, 3 * DIL_GROUPS * DIL_WIDTH, DIL_WIDTH)
IN_WIDTH = Q_LORA + KV_LORA + MLA_ROPE + MLA_WIDTH + 3 * DIL_GROUPS * DIL_WIDTH + DIL_WIDTH

kernel_name = "hymba_mla_dilated_window_encoder"


def rms_norm(x, g):
    xf = x.astype(jnp.float32)
    y = xf * lax.rsqrt(jnp.mean(xf * xf, axis=-1, keepdims=True) + EPS)
    return (y * g.astype(jnp.float32)).astype(x.dtype)


def rope_tables(seq, dim):
    inv = 1.0 / (ROPE_THETA ** (jnp.arange(0, dim, 2, dtype=jnp.float32) / dim))
    ang = jnp.arange(seq, dtype=jnp.float32)[:, None] * inv[None, :]
    return jnp.cos(ang), jnp.sin(ang)


def apply_rope(x, cos, sin):
    xf = x.astype(jnp.float32)
    x1, x2 = jnp.split(xf, 2, axis=-1)
    c = cos[:, None, :]
    s = sin[:, None, :]
    return jnp.concatenate([x1 * c - x2 * s, x1 * s + x2 * c], axis=-1).astype(x.dtype)


def partial_rope(x, cos, sin):
    return jnp.concatenate([apply_rope(x[..., :ROT_DIM], cos, sin), x[..., ROT_DIM:]], axis=-1)


def mla_attention(c_q, c_kv, k_r, q_norm_g, kv_norm_g, w_uq, w_ukv, cos, sin):
    B, S, _ = c_q.shape
    q = (rms_norm(c_q, q_norm_g) @ w_uq).reshape(B, S, MLA_HEADS, MLA_NOPE + MLA_ROPE)
    q_nope = q[..., :MLA_NOPE]
    q_rope = apply_rope(q[..., MLA_NOPE:], cos, sin)
    kv = (rms_norm(c_kv, kv_norm_g) @ w_ukv).reshape(B, S, MLA_HEADS, MLA_NOPE + MLA_V)
    k_nope = kv[..., :MLA_NOPE]
    v = kv[..., MLA_NOPE:]
    k_rope = apply_rope(k_r[:, :, None, :], cos, sin)[:, :, 0, :]
    scale = (MLA_NOPE + MLA_ROPE) ** -0.5
    nb = S // Q_BLOCK
    qn_b = q_nope.reshape(B, nb, Q_BLOCK, MLA_HEADS, MLA_NOPE).swapaxes(0, 1)
    qr_b = q_rope.reshape(B, nb, Q_BLOCK, MLA_HEADS, MLA_ROPE).swapaxes(0, 1)

    def block(args):
        qn, qr = args
        s = (jnp.einsum('bqhd,bkhd->bhqk', qn, k_nope).astype(jnp.float32)
             + jnp.einsum('bqhr,bkr->bhqk', qr, k_rope).astype(jnp.float32)) * scale
        p = jax.nn.softmax(s, axis=-1)
        return jnp.einsum('bhqk,bkhd->bqhd', p.astype(v.dtype), v)

    o = lax.map(block, (qn_b, qr_b))
    return o.swapaxes(0, 1).reshape(B, S, MLA_WIDTH)


def to_strided(t, d):
    B, S = t.shape[:2]
    rest = t.shape[2:]
    return t.reshape(B, S // d, d, *rest).swapaxes(1, 2).reshape(B * d, S // d, *rest)


def from_strided(t, B, d):
    L = t.shape[1]
    rest = t.shape[2:]
    return t.reshape(B, d, L, *rest).swapaxes(1, 2).reshape(B, L * d, *rest)


def banded_attention(q, k, v, half):
    N, L, H, Dh = q.shape
    nb = -(-L // half)
    Lp = nb * half
    pad = Lp - L
    qp = jnp.pad(q, ((0, 0), (0, pad), (0, 0), (0, 0))).reshape(N, nb, half, H, Dh)

    def key_windows(t):
        tp = jnp.pad(t, ((0, 0), (half, pad + half), (0, 0), (0, 0))).reshape(N, nb + 2, half, H, Dh)
        return jnp.concatenate([tp[:, :-2], tp[:, 1:-1], tp[:, 2:]], axis=2)

    kw = key_windows(k)
    vw = key_windows(v)
    qpos = jnp.arange(Lp).reshape(nb, half)
    kpos = (jnp.arange(nb)[:, None] - 1) * half + jnp.arange(3 * half)[None, :]
    valid = ((jnp.abs(qpos[:, :, None] - kpos[:, None, :]) <= half)
             & (kpos[:, None, :] >= 0) & (kpos[:, None, :] < L))
    s = jnp.einsum('nbqhd,nbkhd->nbhqk', qp, kw).astype(jnp.float32) * (Dh ** -0.5)
    s = jnp.where(valid[None, :, None], s, -jnp.inf)
    m = jnp.max(s, axis=-1, keepdims=True)
    e = jnp.exp(s - m)
    l = jnp.sum(e, axis=-1, keepdims=True)
    o = jnp.einsum('nbhqk,nbkhd->nbqhd', (e / l).astype(v.dtype), vw)
    lse = (m + jnp.log(l))[..., 0]
    o = o.reshape(N, Lp, H, Dh)[:, :L]
    lse = lse.swapaxes(2, 3).reshape(N, Lp, H)[:, :L]
    return o, lse


def dilated_attention(dil_qkv, cos, sin):
    B, S, _ = dil_qkv.shape
    qkv = dil_qkv.reshape(B, S, DIL_GROUPS, 3, DIL_HEADS, DIL_HD)
    outs, lses = [], []
    for g, (window, dil) in enumerate(DIL_PAIRS):
        q = partial_rope(qkv[:, :, g, 0], cos, sin)
        k = partial_rope(qkv[:, :, g, 1], cos, sin)
        v = qkv[:, :, g, 2]
        o, lse = banded_attention(to_strided(q, dil), to_strided(k, dil), to_strided(v, dil),
                                  window // (2 * dil))
        outs.append(from_strided(o, B, dil))
        lses.append(from_strided(lse, B, dil))
    alpha = jax.nn.softmax(jnp.stack(lses, axis=0), axis=0)
    out = jnp.einsum('gbsh,gbshd->bshd', alpha, jnp.stack(outs, axis=0).astype(jnp.float32))
    return out.astype(dil_qkv.dtype).reshape(B, S, DIL_WIDTH)


def setup_inputs(seed: int = 0) -> dict:
    key = jax.random.key(seed)
    ks = jax.random.split(key, 10)
    f32 = jnp.float32
    x = jax.random.normal(ks[0], (BATCH, SEQ, D_MODEL), f32)
    norm_g = 1.0 + 0.02 * jax.random.normal(ks[1], (DEPTH, D_MODEL), f32)
    w_in = jax.random.normal(ks[2], (DEPTH, D_MODEL, IN_WIDTH), f32) * D_MODEL ** -0.5
    q_norm_g = 1.0 + 0.02 * jax.random.normal(ks[3], (DEPTH, Q_LORA), f32)
    kv_norm_g = 1.0 + 0.02 * jax.random.normal(ks[4], (DEPTH, KV_LORA), f32)
    w_uq = jax.random.normal(ks[5], (DEPTH, Q_LORA, MLA_HEADS * (MLA_NOPE + MLA_ROPE)), f32) * Q_LORA ** -0.5
    w_ukv = jax.random.normal(ks[6], (DEPTH, KV_LORA, MLA_HEADS * (MLA_NOPE + MLA_V)), f32) * KV_LORA ** -0.5
    w_out = jax.random.normal(ks[7], (DEPTH, MIX_WIDTH, D_MODEL), f32) * MIX_WIDTH ** -0.5
    final_g = 1.0 + 0.02 * jax.random.normal(ks[8], (D_MODEL,), f32)
    return {"x": x, "norm_g": norm_g, "w_in": w_in, "q_norm_g": q_norm_g, "kv_norm_g": kv_norm_g,
            "w_uq": w_uq, "w_ukv": w_ukv, "w_out": w_out, "final_g": final_g}


def reference(x, norm_g, w_in, q_norm_g, kv_norm_g, w_uq, w_ukv, w_out, final_g):
    S = x.shape[1]
    cos_m, sin_m = rope_tables(S, MLA_ROPE)
    cos_d, sin_d = rope_tables(S, ROT_DIM)
    split_points = [sum(IN_SPLITS[:i + 1]) for i in range(len(IN_SPLITS) - 1)]
    for layer in range(DEPTH):
        h = rms_norm(x, norm_g[layer])
        p = h @ w_in[layer]
        c_q, c_kv, k_r, gate_a, dil_qkv, gate_b = jnp.split(p, split_points, axis=-1)
        a = mla_attention(c_q, c_kv, k_r, q_norm_g[layer], kv_norm_g[layer],
                          w_uq[layer], w_ukv[layer], cos_m, sin_m) * jax.nn.silu(gate_a)
        b = dilated_attention(dil_qkv, cos_d, sin_d) * jax.nn.silu(gate_b)
        x = x + jnp.concatenate([a, b], axis=-1) @ w_out[layer]
    return rms_norm(x, final_g)
```

```cpp
#include <hip/hip_runtime.h>
#include <hip/hip_cooperative_groups.h>
#include <cstdio>
#include <cstdint>
#include <cmath>
namespace cg = cooperative_groups;

#define DI __device__ __forceinline__
#define LAS __attribute__((address_space(3)))
typedef unsigned short bf16_t;
typedef short bf16x8 __attribute__((ext_vector_type(8)));
typedef short s16x4 __attribute__((ext_vector_type(4)));
typedef float f32x16 __attribute__((ext_vector_type(16)));
typedef float f32x4 __attribute__((ext_vector_type(4)));
typedef float f32x2 __attribute__((ext_vector_type(2)));
typedef unsigned u32x4 __attribute__((ext_vector_type(4)));
typedef unsigned u32x2 __attribute__((ext_vector_type(2)));
typedef __bf16 bf16x2_t __attribute__((ext_vector_type(2)));
typedef LAS unsigned char* ldsp;
#define MFMA(a, b, c) __builtin_amdgcn_mfma_f32_32x32x16_bf16((a), (b), (c), 0, 0, 0)
#define SB() __builtin_amdgcn_sched_barrier(0)

constexpr int T = 16384, S = 8192, DM = 1024, INW = 6304, INWP = 6400, NLAYER = 4;
constexpr int C_CQ = 0, C_CKV = 384, C_KR = 640, C_GA = 672, C_DQ = 1184, C_GB = 5792;
constexpr float LOG2E = 1.4426950408889634f;
constexpr float EPSN = 1e-6f;

constexpr size_t al256(size_t x) { return (x + 255) & ~(size_t)255; }
constexpr size_t WS_BAR = 0;
constexpr size_t WS_WIN = 16384;
constexpr size_t WS_WUQ = WS_WIN + (size_t)NLAYER * INWP * 1024 * 2;
constexpr size_t WS_WUKV = WS_WUQ + (size_t)NLAYER * 768 * 384 * 2;
constexpr size_t WS_WOUT = WS_WUKV + (size_t)NLAYER * 1024 * 256 * 2;
constexpr size_t WS_COSM = WS_WOUT + (size_t)NLAYER * 1024 * 1024 * 2;
constexpr size_t WS_SINM = WS_COSM + (size_t)S * 16 * 4;
constexpr size_t WS_COSD = WS_SINM + (size_t)S * 16 * 4;
constexpr size_t WS_SIND = WS_COSD + (size_t)S * 8 * 4;
constexpr size_t WS_RSTD = WS_SIND + (size_t)S * 8 * 4;
constexpr size_t WS_RSTDQ = WS_RSTD + (size_t)T * 4;
constexpr size_t WS_RSTDKV = WS_RSTDQ + (size_t)T * 4;
constexpr size_t WS_LSE = WS_RSTDKV + (size_t)T * 4;
constexpr size_t WS_SSQ = WS_LSE + (size_t)3 * T * 8 * 4;
constexpr size_t WS_XB = WS_SSQ + (size_t)NLAYER * T * 4;
constexpr size_t WS_P = WS_XB + (size_t)T * 1024 * 2;
constexpr size_t WS_Q = WS_P + (size_t)T * INW * 2;
constexpr size_t WS_KF = WS_Q + (size_t)T * 768 * 2;
constexpr size_t WS_V = WS_KF + (size_t)T * 8 * 96 * 2;
constexpr size_t WS_END = WS_V + (size_t)T * 8 * 64 * 2;
constexpr size_t WS_CQ = WS_END;
constexpr size_t WS_CKV = WS_CQ + (size_t)T * 384 * 2;
constexpr size_t WS_KR = WS_CKV + (size_t)T * 256 * 2;
constexpr size_t WS_SSQL = WS_KR + (size_t)T * 32 * 2;
constexpr size_t WS_END2 = WS_SSQL + (size_t)NLAYER * 2 * T * 4;
static_assert(WS_END - WS_KF >= (size_t)T * 1024 * 2, "KVB must fit the KF|V region");
constexpr size_t WS_XB2 = WS_Q;
static_assert(WS_KF + (size_t)T * 8 * 96 * 2 - WS_Q >= (size_t)T * 1024 * 2, "XB2 overlay too small");

constexpr int LDS_BYTES = 147456;

struct Params {
    const float* x; const float* norm_g; const float* w_in; const float* q_norm_g; const float* kv_norm_g;
    const float* w_uq; const float* w_ukv; const float* w_out; const float* final_g;
    float* out; unsigned char* ws;
    float inv_m[16]; float inv_d[8];
};

__device__ __forceinline__ const Params& load_params() {
    auto kp = (const __attribute__((address_space(4))) Params*)__builtin_amdgcn_kernarg_segment_ptr();
    asm volatile("" : "+s"(kp));
    return *(const Params*)kp;
}
DI int tid_fresh() { int t = threadIdx.x; asm volatile("" : "+v"(t)); return t; }
DI int vb_fresh(int v) { asm volatile("" : "+s"(v)); return v; }
DI int bid_fresh() { int b = blockIdx.x; asm volatile("" : "+s"(b)); return b; }
DI unsigned pk_bf16(float lo, float hi) { f32x2 v = {lo, hi}; return __builtin_bit_cast(unsigned, __builtin_convertvector(v, bf16x2_t)); }
DI float bf_lo(unsigned u) { return __uint_as_float(u << 16); }
DI float bf_hi(unsigned u) { return __uint_as_float(u & 0xffff0000u); }
DI float wave_sum(float v) {
#pragma unroll
    for (int o = 32; o > 0; o >>= 1) v += __shfl_xor(v, o);
    return v;
}
DI void glds16(const void* gsrc, unsigned lds_dst) { unsigned keep;
    asm volatile("s_mov_b32 %0, m0\n\ts_mov_b32 m0, %2\n\ts_nop 0\n\tglobal_load_lds_dwordx4 %1, off\n\ts_mov_b32 m0, %0" : "=&s"(keep) : "v"(gsrc), "s"(lds_dst) : "memory"); }
DI float silu_f(float x) { return x * __builtin_amdgcn_rcpf(1.0f + __builtin_amdgcn_exp2f(-x * LOG2E)); }

#define XB_TMO      128
#define XB_XCNT(j)  (256  + 64 * (j))
#define XB_XSUB(j)  (1280 + 64 * (j))
#define XB_XGEN(j)  (2304 + 64 * (j))
#define XB_TOP      3328
#define XB_TOPGEN   3392
#define XCD_BAR_WORDS 3456
#define XB_SPIN_CAP (1u << 22)
DI unsigned xb_ld(unsigned* p)              { return __hip_atomic_load(p, __ATOMIC_RELAXED, __HIP_MEMORY_SCOPE_AGENT); }
DI unsigned xb_add(unsigned* p, unsigned v) { return __hip_atomic_fetch_add(p, v, __ATOMIC_RELAXED, __HIP_MEMORY_SCOPE_AGENT); }
DI unsigned xb_xcc_id() { return (unsigned)__builtin_amdgcn_s_getreg((3 << 11) | 20) & 0xFu; }
#define XB_SPIN(cond, bar) do { unsigned _sp = 0; while (cond) { __builtin_amdgcn_s_sleep(1); \
    if ((++_sp & 255u) == 0u) { if (xb_ld(&(bar)[XB_TMO])) break; if (_sp > XB_SPIN_CAP) { atomicAdd(&(bar)[XB_TMO], 1u); break; } } } } while (0)
struct XcdBarrier { unsigned* bar; unsigned x; volatile LAS unsigned* st; };
DI XcdBarrier xcd_barrier_post(unsigned* bar, volatile LAS unsigned* st) {
    XcdBarrier b; b.bar = bar; b.x = xb_xcc_id(); b.st = st;
    if (threadIdx.x == 0) st[2] = xb_add(&bar[XB_XCNT(b.x)], 1u);
    return b;
}
DI void xcd_barrier_complete(unsigned* bar, unsigned x, unsigned& nloc, unsigned& nx) {
    const unsigned G = gridDim.x * gridDim.y * gridDim.z;
    unsigned sum, cnt, mine, sp = 0u;
    for (;;) {
        sum = 0u; cnt = 0u; mine = 0u;
#pragma unroll
        for (unsigned j = 0; j < 16; ++j) { const unsigned c = xb_ld(&bar[XB_XCNT(j)]); sum += c; cnt += (c > 0u) ? 1u : 0u; mine = (j == x) ? c : mine; }
        if (sum == G) break;
        __builtin_amdgcn_s_sleep(1);
        if ((++sp & 255u) == 0u) { if (xb_ld(&bar[XB_TMO])) break; if (sp > XB_SPIN_CAP) { atomicAdd(&bar[XB_TMO], 1u); break; } }
    }
    nloc = mine > 0u ? mine : 1u; nx = cnt > 0u ? cnt : 1u;
}
DI void xcd_barrier(const XcdBarrier& b) {
    asm volatile("s_waitcnt vmcnt(0)" ::: "memory");
    __syncthreads();
    if (threadIdx.x == 0) {
        unsigned* bar = b.bar;
        __builtin_amdgcn_s_waitcnt(0);
        unsigned nloc = b.st[0], nx = b.st[1];
        if (nloc == 0u) { xcd_barrier_complete(bar, b.x, nloc, nx); b.st[0] = nloc; b.st[1] = nx; }
        const unsigned old = xb_add(&bar[XB_XSUB(b.x)], 1u);
        const unsigned gen = old / nloc;
        if (old + 1u == (gen + 1u) * nloc) {
            __builtin_amdgcn_fence(__ATOMIC_RELEASE, "agent");
            asm volatile("s_waitcnt vmcnt(0)" ::: "memory");
            const unsigned og = xb_add(&bar[XB_TOP], 1u);
            const unsigned tg = og / nx;
            if (og + 1u == (tg + 1u) * nx) xb_add(&bar[XB_TOPGEN], 1u);
            else XB_SPIN(xb_ld(&bar[XB_TOPGEN]) == tg, bar);
            __builtin_amdgcn_fence(__ATOMIC_ACQUIRE, "agent");
            xb_add(&bar[XB_XGEN(b.x)], 1u);
            asm volatile("s_waitcnt vmcnt(0)" ::: "memory");
        } else {
            XB_SPIN(xb_ld(&bar[XB_XGEN(b.x)]) == gen, bar);
            __builtin_amdgcn_fence(__ATOMIC_ACQUIRE, "agent");
            asm volatile("s_waitcnt vmcnt(0)" ::: "memory");
        }
    }
    __syncthreads();
}

struct TTile { const float* src; const float* gain; bf16_t* dst; int K, N, k0, n0; };
DI TTile tt_decode(const Params& p, int u) {
    constexpr int TIN = 16 * 100, TUQ = 6 * 12, TUKV = 4 * 16, TOUT = 16 * 16, TL = TIN + TUQ + TUKV + TOUT;
    unsigned char* ws = p.ws;
    const int l = u / TL; int r = u % TL; TTile t;
    if (r < TIN) { t.src = p.w_in + (size_t)l * 1024 * INW; t.gain = p.norm_g + l * 1024; t.dst = (bf16_t*)(ws + WS_WIN) + (size_t)l * INWP * 1024; t.K = 1024; t.N = INW; t.k0 = (r / 100) * 64; t.n0 = (r % 100) * 64; }
    else if ((r -= TIN) < TUQ) { t.src = p.w_uq + (size_t)l * 384 * 768; t.gain = p.q_norm_g + l * 384; t.dst = (bf16_t*)(ws + WS_WUQ) + (size_t)l * 768 * 384; t.K = 384; t.N = 768; t.k0 = (r / 12) * 64; t.n0 = (r % 12) * 64; }
    else if ((r -= TUQ) < TUKV) { t.src = p.w_ukv + (size_t)l * 256 * 1024; t.gain = p.kv_norm_g + l * 256; t.dst = (bf16_t*)(ws + WS_WUKV) + (size_t)l * 1024 * 256; t.K = 256; t.N = 1024; t.k0 = (r / 16) * 64; t.n0 = (r % 16) * 64; }
    else { r -= TUKV; t.src = p.w_out + (size_t)l * 1024 * 1024; t.gain = nullptr; t.dst = (bf16_t*)(ws + WS_WOUT) + (size_t)l * 1024 * 1024; t.K = 1024; t.N = 1024; t.k0 = (r / 16) * 64; t.n0 = (r % 16) * 64; }
    return t;
}

constexpr int TILES_PER_LAYER = 16 * 100 + 6 * 12 + 4 * 16 + 16 * 16;
DI void convert_weights(const Params& p, ldsp lds, int ubeg, int uend, int wg, int nwg) {
    const int tid = tid_fresh();
    const int G = nwg, TOTAL = uend;
    for (int u0 = ubeg + wg; u0 < TOTAL; u0 += 4 * G) {
        float v[4][8];
#pragma unroll
        for (int g = 0; g < 4; ++g)
#pragma unroll
            for (int i = 0; i < 8; ++i) v[g][i] = 0.f;
#pragma unroll
        for (int g = 0; g < 4; ++g) {
            const int u = u0 + g * G;
            if (u < TOTAL) {
                const TTile t = tt_decode(p, u);
#pragma unroll
                for (int i = 0; i < 8; ++i) {
                    const int idx = tid + 512 * i, k = idx >> 6, n = idx & 63;
                    float x = 0.f;
                    if (t.n0 + n < t.N) x = t.src[(size_t)(t.k0 + k) * t.N + t.n0 + n];
                    if (t.gain) x *= t.gain[t.k0 + k];
                    v[g][i] = x;
                }
            }
        }
#pragma unroll
        for (int g = 0; g < 4; ++g) {
            LAS float* tile = (LAS float*)(lds + g * 16640);
#pragma unroll
            for (int i = 0; i < 8; ++i) { const int idx = tid + 512 * i; tile[(idx >> 6) * 65 + (idx & 63)] = v[g][i]; }
        }
        __syncthreads();
#pragma unroll
        for (int g = 0; g < 4; ++g) {
            const int u = u0 + g * G;
            if (u < TOTAL) {
                const TTile t = tt_decode(p, u);
                LAS float* tile = (LAS float*)(lds + g * 16640);
#pragma unroll
                for (int i = 0; i < 4; ++i) {
                    const int idx = tid + 512 * i, n = idx >> 5, k2 = idx & 31;
                    const unsigned w = pk_bf16(tile[(2 * k2) * 65 + n], tile[(2 * k2 + 1) * 65 + n]);
                    *(unsigned*)(t.dst + (size_t)(t.n0 + n) * t.K + t.k0 + 2 * k2) = w;
                }
            }
        }
        __syncthreads();
    }
}

DI void prologue_phase(const Params& p, ldsp lds) {
    unsigned char* ws = p.ws;
    convert_weights(p, lds, 0, TILES_PER_LAYER, bid_fresh(), (int)gridDim.x);
    float* cosm = (float*)(ws + WS_COSM); float* sinm = (float*)(ws + WS_SINM);
    float* cosd = (float*)(ws + WS_COSD); float* sind = (float*)(ws + WS_SIND);
    const int gt = bid_fresh() * 512 + tid_fresh(), gn = gridDim.x * 512;
    for (int i = gt; i < S * 16; i += gn) {
        const int pos = i >> 4, f = i & 15;
        const float ang = (float)pos * p.inv_m[f];
        const double rev = (double)ang * 0.15915494309189535;
        const float fr = (float)(rev - floor(rev));
        cosm[i] = __builtin_amdgcn_cosf(fr); sinm[i] = __builtin_amdgcn_sinf(fr);
    }
    for (int i = gt; i < S * 8; i += gn) {
        const int pos = i >> 3, f = i & 7;
        const float ang = (float)pos * p.inv_d[f];
        const double rev = (double)ang * 0.15915494309189535;
        const float fr = (float)(rev - floor(rev));
        cosd[i] = __builtin_amdgcn_cosf(fr); sind[i] = __builtin_amdgcn_sinf(fr);
    }
}

DI void norm_phase(const float* __restrict__ x, bf16_t* __restrict__ xb, float* __restrict__ rstd) {
    const int tid = tid_fresh(), wave = tid >> 6, lane = tid & 63;
    for (int row = bid_fresh() * 8 + wave; row < T; row += gridDim.x * 8) {
        const f32x4* xr = (const f32x4*)(x + (size_t)row * 1024);
        f32x4 v[4]; float ss = 0.f;
#pragma unroll
        for (int j = 0; j < 4; ++j) { v[j] = xr[lane + 64 * j]; ss += v[j][0] * v[j][0] + v[j][1] * v[j][1] + v[j][2] * v[j][2] + v[j][3] * v[j][3]; }
        ss = wave_sum(ss);
        if (lane == 0) rstd[row] = ss;
#pragma unroll
        for (int j = 0; j < 4; ++j) {
            u32x2 o; o[0] = pk_bf16(v[j][0], v[j][1]); o[1] = pk_bf16(v[j][2], v[j][3]);
            *(u32x2*)(xb + (size_t)row * 1024 + (lane + 64 * j) * 4) = o;
        }
    }
}

DI void final_phase(float* __restrict__ out, const float* __restrict__ g) {
    const int tid = tid_fresh(), wave = tid >> 6, lane = tid & 63;
    for (int row = bid_fresh() * 8 + wave; row < T; row += gridDim.x * 8) {
        f32x4* xr = (f32x4*)(out + (size_t)row * 1024);
        f32x4 v[4]; float ss = 0.f;
#pragma unroll
        for (int j = 0; j < 4; ++j) { v[j] = xr[lane + 64 * j]; ss += v[j][0] * v[j][0] + v[j][1] * v[j][1] + v[j][2] * v[j][2] + v[j][3] * v[j][3]; }
        ss = wave_sum(ss);
        const float rs = __builtin_amdgcn_rsqf(ss * (1.0f / 1024.0f) + EPSN);
#pragma unroll
        for (int j = 0; j < 4; ++j) {
            const f32x4 gg = ((const f32x4*)g)[lane + 64 * j];
            xr[lane + 64 * j] = v[j] * rs * gg;
        }
    }
}

#define GAS __attribute__((address_space(1)))
template <class Epi>
DI void gemm_tile(const bf16_t* __restrict__ W, const bf16_t* __restrict__ A, int lda, int K, int n0, int t0, ldsp lds, const Epi& epi) {
    const int tid = tid_fresh(), wave = tid >> 6, lane = tid & 63, l32 = lane & 31, h = lane >> 5;
    const int wr = wave >> 2, wc = wave & 3;
    const int lrow = tid >> 3, pc = tid & 7, lc = pc ^ ((lrow >> 1) & 7);
    f32x16 acc[4][2];
#pragma unroll
    for (int ni = 0; ni < 4; ++ni)
#pragma unroll
        for (int ti = 0; ti < 2; ++ti)
#pragma unroll
            for (int i = 0; i < 16; ++i) acc[ni][ti][i] = 0.f;
    const bf16_t* wp = W + (size_t)(n0 + lrow) * K + lc * 8;
    const bf16_t* ap = A + (size_t)(t0 + lrow) * lda + lc * 8;
    const int dst = tid * 16;
#define GEMM_DMA(ST, KO) do {                                                                                                       \
        _Pragma("unroll") for (int i_ = 0; i_ < 4; ++i_) {                                                                          \
            __builtin_amdgcn_global_load_lds((const GAS void*)(wp + (size_t)(64 * i_) * K + (KO)), (LAS void*)((ST) + dst + i_ * 8192), 16, 0, 0);           \
            __builtin_amdgcn_global_load_lds((const GAS void*)(ap + (size_t)(64 * i_) * lda + (KO)), (LAS void*)((ST) + 32768 + dst + i_ * 8192), 16, 0, 0); \
        } } while (0)
    GEMM_DMA(lds, 0);
    asm volatile("s_waitcnt vmcnt(0)" ::: "memory");
    __syncthreads();
    const int nk = K >> 6;
    const int swz = (l32 >> 1) & 7;
    const int arow = (wr * 128 + l32) * 128, brow = 32768 + (wc * 64 + l32) * 128;
    int coff[4];
#pragma unroll
    for (int ks = 0; ks < 4; ++ks) coff[ks] = ((2 * ks + h) ^ swz) << 4;
    for (int kt = 0; kt < nk; ++kt) {
        ldsp cur = lds + (kt & 1) * 65536;
        if (kt + 1 < nk) { ldsp nxt = lds + ((kt + 1) & 1) * 65536; GEMM_DMA(nxt, (kt + 1) * 64); }
        {
            bf16x8 af[2][4], bfr[2][2];
#pragma unroll
            for (int ni = 0; ni < 4; ++ni) af[0][ni] = *(LAS bf16x8*)(cur + arow + ni * 4096 + coff[0]);
#pragma unroll
            for (int ti = 0; ti < 2; ++ti) bfr[0][ti] = *(LAS bf16x8*)(cur + brow + ti * 4096 + coff[0]);
#pragma unroll
            for (int ks = 0; ks < 4; ++ks) {
                if (ks < 3) {
#pragma unroll
                    for (int ni = 0; ni < 4; ++ni) af[(ks + 1) & 1][ni] = *(LAS bf16x8*)(cur + arow + ni * 4096 + coff[(ks + 1) & 3]);
#pragma unroll
                    for (int ti = 0; ti < 2; ++ti) bfr[(ks + 1) & 1][ti] = *(LAS bf16x8*)(cur + brow + ti * 4096 + coff[(ks + 1) & 3]);
                }
                SB();
#pragma unroll
                for (int ni = 0; ni < 4; ++ni)
#pragma unroll
                    for (int ti = 0; ti < 2; ++ti) acc[ni][ti] = MFMA(af[ks & 1][ni], bfr[ks & 1][ti], acc[ni][ti]);
                SB();
            }
        }
        asm volatile("s_waitcnt vmcnt(0)" ::: "memory");
        __syncthreads();
    }
#undef GEMM_DMA
    epi(acc, n0 + wr * 128, t0 + wc * 64, l32, h);
}

struct EpiRowScaleBf16 {
    bf16_t* O; int ld; const float* rs; int nmax;
    DI void operator()(const f32x16 (&acc)[4][2], int nb, int tb, int l32, int h) const {
#pragma unroll
        for (int ti = 0; ti < 2; ++ti) {
            const int t = tb + ti * 32 + l32; const float r = rs[t]; bf16_t* row = O + (size_t)t * ld;
#pragma unroll
            for (int ni = 0; ni < 4; ++ni)
#pragma unroll
                for (int g = 0; g < 4; ++g) {
                    const int n = nb + ni * 32 + 8 * g + 4 * h;
                    if (n < nmax) { u32x2 o; o[0] = pk_bf16(acc[ni][ti][4 * g] * r, acc[ni][ti][4 * g + 1] * r); o[1] = pk_bf16(acc[ni][ti][4 * g + 2] * r, acc[ni][ti][4 * g + 3] * r);
                        *(u32x2*)(row + n) = o; }
                }
        }
    }
};
struct EpiKV {
    bf16_t* KF; bf16_t* V; const float* rs;
    DI void operator()(const f32x16 (&acc)[4][2], int nb, int tb, int l32, int h) const {
#pragma unroll
        for (int ti = 0; ti < 2; ++ti) {
            const int t = tb + ti * 32 + l32; const float r = rs[t]; const int b = t >> 13, s = t & 8191;
#pragma unroll
            for (int ni = 0; ni < 4; ++ni)
#pragma unroll
                for (int g = 0; g < 4; ++g) {
                    const int n = nb + ni * 32 + 8 * g + 4 * h; const int head = n >> 7, w = n & 127;
                    u32x2 o; o[0] = pk_bf16(acc[ni][ti][4 * g] * r, acc[ni][ti][4 * g + 1] * r); o[1] = pk_bf16(acc[ni][ti][4 * g + 2] * r, acc[ni][ti][4 * g + 3] * r);
                    const size_t rowi = (size_t)(b * 8 + head) * 8192 + s;
                    bf16_t* dst = (w < 64) ? (KF + rowi * 96 + w) : (V + rowi * 64 + (w - 64));
                    *(u32x2*)dst = o;
                }
        }
    }
};
struct EpiResid {
    float* out; const float* resid;
    DI void operator()(const f32x16 (&acc)[4][2], int nb, int tb, int l32, int h) const {
#pragma unroll
        for (int ti = 0; ti < 2; ++ti) {
            const int t = tb + ti * 32 + l32;
#pragma unroll
            for (int ni = 0; ni < 4; ++ni)
#pragma unroll
                for (int g = 0; g < 4; ++g) {
                    const int n = nb + ni * 32 + 8 * g + 4 * h;
                    f32x4 r = *(const f32x4*)(resid + (size_t)t * 1024 + n);
                    r[0] += acc[ni][ti][4 * g]; r[1] += acc[ni][ti][4 * g + 1]; r[2] += acc[ni][ti][4 * g + 2]; r[3] += acc[ni][ti][4 * g + 3];
                    *(f32x4*)(out + (size_t)t * 1024 + n) = r;
                    if (g == 3) __builtin_amdgcn_sched_barrier(0);
                }
        }
    }
};

namespace pg8 {
#define PG8_LAS __attribute__((address_space(3)))
typedef unsigned short bf16_t;
typedef short bf16x8 __attribute__((ext_vector_type(8)));
typedef float f32x4 __attribute__((ext_vector_type(4)));
typedef unsigned u32x4 __attribute__((ext_vector_type(4)));
constexpr int BM = 256, BK = 64, HALF = 128, HTB = HALF * BK * 2  , STAGE_BYTES = 8 * HTB, NXCD = 8, WGM = 8;

__host__ __device__ __forceinline__ int lds_byte(int r, int c) { const int st = (r >> 4) * 2 + (c >> 5), rr = r & 15, cc = c & 31, ob = rr * 64 + cc * 2; return st * 1024 + (ob ^ (((ob >> 9) & 1) << 5)); }
__host__ __device__ __forceinline__ void stage_rc(int b, int& R, int& C) { const int st = b / 1024, sb = b % 1024, swz = sb ^ (((sb >> 9) & 1) << 5); R = (st >> 1) * 16 + swz / 64; C = (st & 1) * 32 + (swz % 64) / 2; }
__host__ __device__ __forceinline__ int perm32(int rho) { const int n = rho >> 4, i = rho & 15; return 8 * (i >> 2) + 4 * n + (i & 3); }

struct Unit { int pm, pn; };
struct Gemm { const bf16_t* A; const bf16_t* Bt; int M, N, K; };

struct StaticOrder {
    int nM, nN, nwg, G, c;
    __host__ __device__ void init(int M, int N, int G_, int c_) { nM = M / BM; nN = N / BM; nwg = nM * nN; G = G_; c = c_; }
    __host__ __device__ bool next(int i, Unit& u) const {
        const long L = (long)i * G + c; if (L >= nwg) return false;
        int wgid = (int)L; { const int q = nwg / NXCD, r = nwg % NXCD, xcd = wgid % NXCD, off = wgid / NXCD; wgid = (xcd < r ? xcd * (q + 1) : r * (q + 1) + (xcd - r) * q) + off; }
        const int nig = WGM * nN, gid = wgid / nig, fm = gid * WGM, gsz = (nM - fm) < WGM ? (nM - fm) : WGM;
        u.pm = fm + ((wgid % nig) % gsz); u.pn = (wgid % nig) / gsz; return true;
    }
    __device__ __forceinline__ void a_ready(const Unit&) const {}
    __device__ __forceinline__ void done(const Unit&) const {}
};
template <class Epi, class Sched, bool ALIGN_EPI = false, bool SP2 = false>
__device__ __forceinline__ void gemm_phase(PG8_LAS unsigned char* lds, const Gemm g, const Sched& S, const Epi& E) {
    const int tid = tid_fresh(), wid = __builtin_amdgcn_readfirstlane(tid >> 6), lane = tid & 63, wr = wid >> 2, wc = wid & 3, fr = lane & 15, fq = lane >> 4;
    const int K = g.K, nt = K / BK;
    unsigned voffA[2], voffB[2];
#pragma unroll
    for (int i = 0; i < 2; ++i) { int R, C; stage_rc(tid * 16 + i * 8192, R, C); const int Rb = Epi::PERM ? ((R & ~31) + perm32(R & 31)) : R;
        voffA[i] = (unsigned)(R * K + C) * 2u; voffB[i] = (unsigned)(Rb * K + C) * 2u; }
    const size_t kstep = (size_t)(BK * 2);
    const size_t hstep = (size_t)HALF * K * 2;
    const size_t tstep = 2 * hstep;
    const unsigned ldsw = (unsigned)wid * 1024u;
    const int aoff = lds_byte(wr * 64 + fr, fq * 8), boff = lds_byte(wc * 32 + fr, fq * 8);
#define PG8_SA(b, h) (((b) * 2 + (h)) * HTB)
#define PG8_SB(b, h) ((4 + (b) * 2 + (h)) * HTB)
#define PG8_STAGE(bufoff, gbase, voff) do { _Pragma("unroll") for (int _i = 0; _i < 2; ++_i) \
        __builtin_amdgcn_global_load_lds((const unsigned*)((const char*)(gbase) + (voff)[_i]), (PG8_LAS unsigned*)(lds + (bufoff) + ldsw + _i * 8192), 16, 0, 0); } while (0)
#define PG8_LDA(dst, b, h) do { _Pragma("unroll") for (int m = 0; m < 4; ++m) _Pragma("unroll") for (int k = 0; k < 2; ++k) dst[m][k] = *(const PG8_LAS bf16x8*)(lds + PG8_SA(b, h) + aoff + m * 2048 + k * 1024); } while (0)
#define PG8_LDB(dst, b, h) do { _Pragma("unroll") for (int n = 0; n < 2; ++n) _Pragma("unroll") for (int k = 0; k < 2; ++k) dst[n][k] = *(const PG8_LAS bf16x8*)(lds + PG8_SB(b, h) + boff + n * 2048 + k * 1024); } while (0)
#define PG8_MMA(ai, bj, At, Bt) do { __builtin_amdgcn_s_setprio(1); _Pragma("unroll") for (int m = 0; m < 4; ++m) _Pragma("unroll") for (int n = 0; n < 2; ++n) _Pragma("unroll") for (int k = 0; k < 2; ++k) \
        acc[ai][bj][m][n] = __builtin_amdgcn_mfma_f32_16x16x32_bf16(Bt[n][k], At[m][k], acc[ai][bj][m][n], 0, 0, 0); __builtin_amdgcn_s_setprio(0); } while (0)
#define PG8_WAIT_V(n) asm volatile("s_waitcnt vmcnt(" #n ")" ::: "memory")
#define PG8_WAIT_L(n) asm volatile("s_waitcnt lgkmcnt(" #n ")" ::: "memory")
#define PG8_BAR __builtin_amdgcn_s_barrier()
#define PG8_SCHED __builtin_amdgcn_sched_barrier(0)
    Unit cur, nxt; int ui = 0;
    if (!S.next(0, cur)) return;
    f32x4 acc[2][2][4][2];
#pragma unroll
    for (int a = 0; a < 2; ++a)
#pragma unroll
        for (int b = 0; b < 2; ++b)
#pragma unroll
            for (int m = 0; m < 4; ++m)
#pragma unroll
                for (int n = 0; n < 2; ++n) acc[a][b][m][n] = (f32x4){0.f, 0.f, 0.f, 0.f};
    bf16x8 At[4][2], B0[2][2], B1[2][2];
    const char* cA = (const char*)g.A + (size_t)cur.pm * tstep; const char* cB = (const char*)g.Bt + (size_t)cur.pn * tstep;
    S.a_ready(cur);
    if constexpr (SP2) {
        PG8_STAGE(PG8_SB(0, 0), cB, voffB); PG8_STAGE(PG8_SB(0, 1), cB + hstep, voffB); PG8_STAGE(PG8_SA(0, 0), cA, voffA); PG8_STAGE(PG8_SA(0, 1), cA + hstep, voffA);
        if (wr == 1) PG8_BAR;
        PG8_WAIT_V(2); PG8_BAR;
        PG8_STAGE(PG8_SB(1, 0), cB + kstep, voffB); PG8_STAGE(PG8_SA(1, 0), cA + kstep, voffA); PG8_STAGE(PG8_SB(1, 1), cB + hstep + kstep, voffB);
        PG8_WAIT_V(6); PG8_BAR;
    } else {
        PG8_STAGE(PG8_SB(0, 0), cB, voffB); PG8_STAGE(PG8_SA(0, 0), cA, voffA); PG8_STAGE(PG8_SB(0, 1), cB + hstep, voffB); PG8_STAGE(PG8_SA(0, 1), cA + hstep, voffA);
        if (wr == 1) PG8_BAR;
        PG8_WAIT_V(4); PG8_BAR;
        PG8_STAGE(PG8_SB(1, 0), cB + kstep, voffB); PG8_STAGE(PG8_SA(1, 0), cA + kstep, voffA); PG8_STAGE(PG8_SB(1, 1), cB + hstep + kstep, voffB);
        PG8_WAIT_V(6); PG8_BAR;
    }
    for (;;) {
        const bool has_next = S.next(ui + 1, nxt);
        const char* nA = has_next ? (const char*)g.A + (size_t)nxt.pm * tstep : cA; const char* nB = has_next ? (const char*)g.Bt + (size_t)nxt.pn * tstep : cB;
        for (int t = 0; t < nt; t += 2) {
            const bool last = (t == nt - 2);
            const char* a1 = cA + (size_t)(t + 1) * kstep;
            const char* a2 = last ? nA : cA + (size_t)(t + 2) * kstep; const char* b2 = last ? nB : cB + (size_t)(t + 2) * kstep;
            const char* a3 = a2 + kstep; const char* b3 = b2 + kstep;
            if (last && has_next) S.a_ready(nxt);
            if constexpr (SP2) {
            PG8_LDB(B0, 0, 0); PG8_LDB(B1, 0, 1); PG8_SCHED; PG8_LDA(At, 0, 0); PG8_STAGE(PG8_SA(1, 1), a1 + hstep, voffA);
            PG8_WAIT_V(8); PG8_WAIT_L(0); PG8_BAR; PG8_MMA(0, 0, At, B0); PG8_MMA(0, 1, At, B1); PG8_BAR; PG8_SCHED;
            PG8_LDA(At, 0, 1); PG8_STAGE(PG8_SB(0, 0), b2, voffB); PG8_STAGE(PG8_SB(0, 1), b2 + hstep, voffB); PG8_STAGE(PG8_SA(0, 0), a2, voffA);
            PG8_WAIT_V(8); PG8_WAIT_L(0); PG8_BAR; PG8_MMA(1, 0, At, B0); PG8_MMA(1, 1, At, B1); PG8_BAR; PG8_SCHED;
            PG8_LDB(B0, 1, 0); PG8_LDB(B1, 1, 1); PG8_SCHED; PG8_LDA(At, 1, 0); PG8_STAGE(PG8_SA(0, 1), a2 + hstep, voffA);
            PG8_WAIT_V(8); PG8_WAIT_L(0); PG8_BAR; PG8_MMA(0, 0, At, B0); PG8_MMA(0, 1, At, B1); PG8_BAR; PG8_SCHED;
            PG8_LDA(At, 1, 1); PG8_STAGE(PG8_SB(1, 0), b3, voffB); PG8_STAGE(PG8_SB(1, 1), b3 + hstep, voffB); PG8_STAGE(PG8_SA(1, 0), a3, voffA);
            PG8_WAIT_V(8); PG8_WAIT_L(0); PG8_BAR; PG8_MMA(1, 0, At, B0); PG8_MMA(1, 1, At, B1); PG8_BAR; PG8_SCHED;
            } else {
            PG8_LDB(B0, 0, 0); PG8_SCHED; PG8_LDA(At, 0, 0); PG8_STAGE(PG8_SA(1, 1), a1 + hstep, voffA);
            PG8_WAIT_L(8); PG8_BAR; PG8_WAIT_L(0); PG8_MMA(0, 0, At, B0); PG8_BAR; PG8_SCHED;
            PG8_LDB(B1, 0, 1); PG8_STAGE(PG8_SB(0, 0), b2, voffB);
            PG8_BAR; PG8_WAIT_L(0); PG8_MMA(0, 1, At, B1); PG8_BAR;
            PG8_LDA(At, 0, 1); PG8_STAGE(PG8_SA(0, 0), a2, voffA);
            PG8_BAR; PG8_WAIT_L(0); PG8_MMA(1, 0, At, B0); PG8_BAR; PG8_SCHED;
            PG8_STAGE(PG8_SB(0, 1), b2 + hstep, voffB);
            PG8_WAIT_V(6); PG8_BAR; PG8_MMA(1, 1, At, B1); PG8_BAR;
            PG8_LDB(B0, 1, 0); PG8_SCHED; PG8_LDA(At, 1, 0); PG8_STAGE(PG8_SA(0, 1), a2 + hstep, voffA);
            PG8_WAIT_L(8); PG8_BAR; PG8_WAIT_L(0); PG8_MMA(0, 0, At, B0); PG8_BAR; PG8_SCHED;
            PG8_LDB(B1, 1, 1); PG8_STAGE(PG8_SB(1, 0), b3, voffB);
            PG8_BAR; PG8_WAIT_L(0); PG8_MMA(0, 1, At, B1); PG8_BAR;
            PG8_LDA(At, 1, 1); PG8_STAGE(PG8_SA(1, 0), a3, voffA);
            PG8_BAR; PG8_WAIT_L(0); PG8_MMA(1, 0, At, B0); PG8_BAR; PG8_SCHED;
            PG8_STAGE(PG8_SB(1, 1), b3 + hstep, voffB);
            PG8_WAIT_V(6); PG8_BAR; PG8_MMA(1, 1, At, B1); PG8_BAR;
            }
        }
        if constexpr (ALIGN_EPI) { if (wr == 0) PG8_BAR; }
        if constexpr (!Epi::AFTER_DRAIN) { E(acc, cur, wr, wc, fr, fq); S.done(cur); }
        if (!has_next) break;
#pragma unroll
        for (int a = 0; a < 2; ++a)
#pragma unroll
            for (int b = 0; b < 2; ++b)
#pragma unroll
                for (int m = 0; m < 4; ++m)
#pragma unroll
                    for (int n = 0; n < 2; ++n) acc[a][b][m][n] = (f32x4){0.f, 0.f, 0.f, 0.f};
        cur = nxt; cA = nA; cB = nB; ++ui;
        if constexpr (ALIGN_EPI) { if (wr == 1) PG8_BAR; }
    }
    PG8_WAIT_V(0);
    if constexpr (!ALIGN_EPI) { if (wr == 0) PG8_BAR; }
    PG8_BAR;
    if constexpr (Epi::AFTER_DRAIN) { E.fused(acc, cur, wr, wc, fr, fq, lds, wid, lane); S.done(cur); }
#undef PG8_SA
#undef PG8_SB
#undef PG8_STAGE
#undef PG8_LDA
#undef PG8_LDB
#undef PG8_MMA
#undef PG8_WAIT_V
#undef PG8_WAIT_L
#undef PG8_BAR
#undef PG8_SCHED
}
}

struct EpiInproj {
    static constexpr bool PERM = true, AFTER_DRAIN = false;
    bf16_t* O; const float* rs; bf16_t* CQ; bf16_t* CKV; float* ssq_q; float* ssq_kv; bf16_t* KR; const float* cosm; const float* sinm;
    DI void operator()(const pg8::f32x4 (&acc)[2][2][4][2], const pg8::Unit& u, int wr, int wc, int fr, int fq) const {
        const int row0 = u.pm * 256 + wr * 64 + fr, col0 = u.pn * 256 + wc * 32 + 8 * fq;
        const bool lat = u.pn < 3;
#pragma unroll
        for (int ai = 0; ai < 2; ++ai)
#pragma unroll
            for (int m = 0; m < 4; ++m) {
                const int row = row0 + ai * 128 + m * 16; const float r = __builtin_amdgcn_rsqf(rs[row] * (1.0f / 1024.0f) + EPSN);
                float sq = 0.f, skv = 0.f;
#pragma unroll
                for (int bj = 0; bj < 2; ++bj) {
                    const int c = col0 + bj * 128;
                    if (c < INW) {
                        const pg8::f32x4 v0 = acc[ai][bj][m][0] * r, v1 = acc[ai][bj][m][1] * r;
                        u32x4 w; w[0] = pk_bf16(v0[0], v0[1]); w[1] = pk_bf16(v0[2], v0[3]); w[2] = pk_bf16(v1[0], v1[1]); w[3] = pk_bf16(v1[2], v1[3]);
                        bf16_t* dst = (c < C_CKV) ? (CQ + (unsigned)(row * 384 + c)) : (c < C_KR) ? (CKV + (unsigned)(row * 256 + (c - C_CKV))) : (O + (unsigned)(row * INW + c));
                        *(u32x4*)dst = w;
                        if (lat && c < C_KR) {
                            float s = 0.f;
#pragma unroll
                            for (int e = 0; e < 4; ++e) { const float a = bf_lo(w[e]), b = bf_hi(w[e]); s += a * a + b * b; }
                            if (c < C_CKV) sq += s; else skv += s;
                        }
                        if (lat && u.pn == 2 && bj == 1 && wc == 0) {
                            float own[8], par[8];
#pragma unroll
                            for (int e = 0; e < 4; ++e) { own[2 * e] = bf_lo(w[e]); own[2 * e + 1] = bf_hi(w[e]); }
#pragma unroll
                            for (int e = 0; e < 8; ++e) par[e] = __shfl_xor(own[e], 32);
                            const int spos = row & 8191, i0 = 8 * (fq & 1);
                            const f32x4 c0 = *(const f32x4*)(cosm + spos * 16 + i0), c1 = *(const f32x4*)(cosm + spos * 16 + i0 + 4);
                            const f32x4 s0 = *(const f32x4*)(sinm + spos * 16 + i0), s1 = *(const f32x4*)(sinm + spos * 16 + i0 + 4);
                            const float cc[8] = {c0[0], c0[1], c0[2], c0[3], c1[0], c1[1], c1[2], c1[3]};
                            const float sn[8] = {s0[0], s0[1], s0[2], s0[3], s1[0], s1[1], s1[2], s1[3]};
                            float y[8];
#pragma unroll
                            for (int e = 0; e < 8; ++e) y[e] = (fq < 2) ? (own[e] * cc[e] - par[e] * sn[e]) : (par[e] * sn[e] + own[e] * cc[e]);
                            u32x4 kw; kw[0] = pk_bf16(y[0], y[1]); kw[1] = pk_bf16(y[2], y[3]); kw[2] = pk_bf16(y[4], y[5]); kw[3] = pk_bf16(y[6], y[7]);
                            *(u32x4*)(KR + (unsigned)(row * 32 + 8 * fq)) = kw;
                        }
                    }
                }
                if (lat) {
                    sq += __shfl_xor(sq, 16); sq += __shfl_xor(sq, 32);
                    skv += __shfl_xor(skv, 16); skv += __shfl_xor(skv, 32);
                    if (fq == 0) {
                        if (u.pn < 2) (void)__hip_atomic_fetch_add(ssq_q + row, sq, __ATOMIC_RELAXED, __HIP_MEMORY_SCOPE_AGENT);
                        if (u.pn > 0) (void)__hip_atomic_fetch_add(ssq_kv + row, skv, __ATOMIC_RELAXED, __HIP_MEMORY_SCOPE_AGENT);
                    }
                }
            }
    }
};
struct EpiOutRes {
    static constexpr bool PERM = false, AFTER_DRAIN = false;
    float* out; const float* resid; bf16_t* xb; float* ssq;
    DI void operator()(const pg8::f32x4 (&acc)[2][2][4][2], const pg8::Unit& u, int wr, int wc, int fr, int fq) const {
        const int row0 = u.pm * 256 + wr * 64 + fr, col0 = u.pn * 256 + wc * 32 + 4 * fq;
        float ssum[2][4];
        f32x4 rb[2][2][2][2];
#define EPI_LOAD(BUF, AI, M0) do { _Pragma("unroll") for (int mm = 0; mm < 2; ++mm) _Pragma("unroll") for (int bj = 0; bj < 2; ++bj) _Pragma("unroll") for (int n = 0; n < 2; ++n) \
            rb[BUF][mm][bj][n] = *(const f32x4*)(resid + (size_t)(row0 + (AI) * 128 + ((M0) + mm) * 16) * 1024 + col0 + bj * 128 + n * 16); } while (0)
#define EPI_USE(BUF, AI, M0) do { _Pragma("unroll") for (int mm = 0; mm < 2; ++mm) { const size_t ro = (size_t)(row0 + (AI) * 128 + ((M0) + mm) * 16) * 1024 + col0; float s = 0.f; \
            _Pragma("unroll") for (int bj = 0; bj < 2; ++bj) _Pragma("unroll") for (int n = 0; n < 2; ++n) { \
                const f32x4 r = rb[BUF][mm][bj][n] + acc[AI][bj][(M0) + mm][n]; \
                *(f32x4*)(out + ro + bj * 128 + n * 16) = r; \
                if (ssq) { u32x2 w; w[0] = pk_bf16(r[0], r[1]); w[1] = pk_bf16(r[2], r[3]); *(u32x2*)(xb + ro + bj * 128 + n * 16) = w; \
                           s += r[0] * r[0] + r[1] * r[1] + r[2] * r[2] + r[3] * r[3]; } } \
            ssum[AI][(M0) + mm] = s; } } while (0)
        EPI_LOAD(0, 0, 0); SB();
        EPI_LOAD(1, 0, 2); SB();
        EPI_USE(0, 0, 0); SB();
        EPI_LOAD(0, 1, 0); SB();
        EPI_USE(1, 0, 2); SB();
        EPI_LOAD(1, 1, 2); SB();
        EPI_USE(0, 1, 0); SB();
        EPI_USE(1, 1, 2); SB();
#undef EPI_LOAD
#undef EPI_USE
        if (ssq) {
#pragma unroll
            for (int ai = 0; ai < 2; ++ai)
#pragma unroll
                for (int m = 0; m < 4; ++m) {
                    float s = ssum[ai][m];
                    s += __shfl_xor(s, 16); s += __shfl_xor(s, 32);
                    if (fq == 0) (void)__hip_atomic_fetch_add(ssq + row0 + ai * 128 + m * 16, s, __ATOMIC_RELAXED, __HIP_MEMORY_SCOPE_AGENT);
                }
        }
    }
};

struct EpiUpRow {
    static constexpr bool PERM = true, AFTER_DRAIN = false;
    bf16_t* O; const float* ss; int ld; float invk;
    DI void operator()(const pg8::f32x4 (&acc)[2][2][4][2], const pg8::Unit& u, int wr, int wc, int fr, int fq) const {
        const int row0 = u.pm * 256 + wr * 64 + fr, col0 = u.pn * 256 + wc * 32 + 8 * fq;
#pragma unroll
        for (int ai = 0; ai < 2; ++ai)
#pragma unroll
            for (int m = 0; m < 4; ++m) {
                const int row = row0 + ai * 128 + m * 16; const float r = __builtin_amdgcn_rsqf(ss[row] * invk + EPSN);
#pragma unroll
                for (int bj = 0; bj < 2; ++bj) {
                    const pg8::f32x4 v0 = acc[ai][bj][m][0] * r, v1 = acc[ai][bj][m][1] * r;
                    u32x4 w; w[0] = pk_bf16(v0[0], v0[1]); w[1] = pk_bf16(v0[2], v0[3]); w[2] = pk_bf16(v1[0], v1[1]); w[3] = pk_bf16(v1[2], v1[3]);
                    *(u32x4*)(O + (unsigned)(row * ld + col0 + bj * 128)) = w;
                }
                SB();
            }
    }
};
DI void latent_phase(const Params& p) {
    unsigned char* ws = p.ws;
    bf16_t* P = (bf16_t*)(ws + WS_P); bf16_t* KR = (bf16_t*)(ws + WS_KR);
    float* rstdq = (float*)(ws + WS_RSTDQ); float* rstdkv = (float*)(ws + WS_RSTDKV);
    const bf16_t* CQb = (const bf16_t*)(ws + WS_CQ); const bf16_t* CKVb = (const bf16_t*)(ws + WS_CKV);
    const float* cosm = (const float*)(ws + WS_COSM); const float* sinm = (const float*)(ws + WS_SINM);
    const float* cosd = (const float*)(ws + WS_COSD); const float* sind = (const float*)(ws + WS_SIND);
    const int tid = tid_fresh(), wave = tid >> 6, lane = tid & 63;
    for (int t = bid_fresh() * 8 + wave; t < T; t += gridDim.x * 8) {
        bf16_t* prow = P + (size_t)t * INW; const int s = t & 8191, b = t >> 13;
        float sq = 0.f, skv = 0.f;
#pragma unroll
        for (int i = 0; i < 3; ++i) { const unsigned u = ((const unsigned*)(CQb + (size_t)t * 384))[lane + 64 * i]; const float a = bf_lo(u), c = bf_hi(u); sq += a * a + c * c; }
#pragma unroll
        for (int i = 0; i < 2; ++i) { const unsigned u = ((const unsigned*)(CKVb + (size_t)t * 256))[lane + 64 * i]; const float a = bf_lo(u), c = bf_hi(u); skv += a * a + c * c; }
        sq = wave_sum(sq); skv = wave_sum(skv);
        if (lane == 0) { rstdq[t] = __builtin_amdgcn_rsqf(sq * (1.0f / 384.0f) + EPSN); rstdkv[t] = __builtin_amdgcn_rsqf(skv * (1.0f / 256.0f) + EPSN); }
        {
            const int hd = lane >> 3, vb = (lane & 7) * 4, i0 = vb & 15; const bool second = vb >= 16;
            const u32x2 a1 = *(const u32x2*)(prow + C_KR + i0), a2 = *(const u32x2*)(prow + C_KR + 16 + i0);
            const f32x4 c = *(const f32x4*)(cosm + s * 16 + i0), sn = *(const f32x4*)(sinm + s * 16 + i0);
            const float x1[4] = {bf_lo(a1[0]), bf_hi(a1[0]), bf_lo(a1[1]), bf_hi(a1[1])};
            const float x2[4] = {bf_lo(a2[0]), bf_hi(a2[0]), bf_lo(a2[1]), bf_hi(a2[1])};
            float y[4];
#pragma unroll
            for (int e = 0; e < 4; ++e) y[e] = second ? (x1[e] * sn[e] + x2[e] * c[e]) : (x1[e] * c[e] - x2[e] * sn[e]);
            u32x2 o; o[0] = pk_bf16(y[0], y[1]); o[1] = pk_bf16(y[2], y[3]);
            if (hd == 0) *(u32x2*)(KR + (size_t)t * 32 + vb) = o;
        }
    }
}

DI void dil_item(const Params& p, int it, ldsp lds) {
    unsigned char* ws = p.ws;
    bf16_t* P = (bf16_t*)(ws + WS_P); float* LSE = (float*)(ws + WS_LSE);
    const float* cosd = (const float*)(ws + WS_COSD); const float* sind = (const float*)(ws + WS_SIND);
    const int tid = tid_fresh(), wave = tid >> 6, lane = tid & 63, l32 = lane & 31, h = lane >> 5;
    const int g = it >> 9, rem = it & 511, b = rem >> 8, head = (rem >> 5) & 7, blk = rem & 31;
    const int dsh = 2 * g, L = 8192 >> dsh;
    const int j = blk >> (5 - dsh), rb = blk & ((32 >> dsh) - 1), r0 = rb * 256;
    bf16_t* Pb = P + (size_t)(b * 8192) * INW + C_DQ + g * 1536 + head * 64;
    {
        u32x4 kreg[6], vreg[6];
#pragma unroll
        for (int i = 0; i < 6; ++i) {
            const int c = tid + 512 * i, row = c >> 3, ch = c & 7, r = r0 - 64 + row;
            const bool valid = (r >= 0) && (r < L);
            const int s = j + ((valid ? r : 0) << dsh);
            const bf16_t* src = Pb + (size_t)s * INW + ch * 8;
            u32x4 z = {0u, 0u, 0u, 0u};
            kreg[i] = valid ? *(const u32x4*)(src + 512) : z;
            vreg[i] = valid ? *(const u32x4*)(src + 1024) : z;
            u32x4 pw;
#pragma unroll
            for (int e = 0; e < 4; ++e) pw[e] = __shfl_xor(kreg[i][e], 1);
            if (ch < 2) {
                const f32x4 c0 = *(const f32x4*)(cosd + s * 8), c1 = *(const f32x4*)(cosd + s * 8 + 4);
                const f32x4 s0 = *(const f32x4*)(sind + s * 8), s1 = *(const f32x4*)(sind + s * 8 + 4);
                const float cc[8] = {c0[0], c0[1], c0[2], c0[3], c1[0], c1[1], c1[2], c1[3]};
                const float ss[8] = {s0[0], s0[1], s0[2], s0[3], s1[0], s1[1], s1[2], s1[3]};
                const u32x4 own = kreg[i];
                u32x4 res;
#pragma unroll
                for (int e = 0; e < 4; ++e) {
                    const float x1l = ch == 0 ? bf_lo(own[e]) : bf_lo(pw[e]), x1h = ch == 0 ? bf_hi(own[e]) : bf_hi(pw[e]);
                    const float x2l = ch == 0 ? bf_lo(pw[e]) : bf_lo(own[e]), x2h = ch == 0 ? bf_hi(pw[e]) : bf_hi(own[e]);
                    const float yl = ch == 0 ? (x1l * cc[2 * e] - x2l * ss[2 * e]) : (x1l * ss[2 * e] + x2l * cc[2 * e]);
                    const float yh = ch == 0 ? (x1h * cc[2 * e + 1] - x2h * ss[2 * e + 1]) : (x1h * ss[2 * e + 1] + x2h * cc[2 * e + 1]);
                    res[e] = pk_bf16(yl, yh);
                }
                kreg[i] = res;
            }
        }
#pragma unroll
        for (int i = 0; i < 6; ++i) {
            const int c = tid + 512 * i, row = c >> 3, ch = c & 7;
            *(LAS u32x4*)(lds + row * 144 + ch * 16) = kreg[i];
            *(LAS u32x4*)(lds + 55296 + row * 128 + ((ch ^ (((row >> 1) & 1) << 2)) << 4)) = vreg[i];
        }
    }
    __syncthreads();
    const int rq = r0 + wave * 32 + l32, sq = j + (rq << dsh);
    bf16_t* qrow = Pb + (size_t)sq * INW;
    bf16x8 qf[4];
#pragma unroll
    for (int ks = 0; ks < 4; ++ks) qf[ks] = *(const bf16x8*)(qrow + ks * 16 + h * 8);
    {
        const u32x4 own = __builtin_bit_cast(u32x4, qf[0]);
        u32x4 pw, res;
#pragma unroll
        for (int e = 0; e < 4; ++e) pw[e] = __shfl_xor(own[e], 32);
        const f32x4 c0 = *(const f32x4*)(cosd + sq * 8), c1 = *(const f32x4*)(cosd + sq * 8 + 4);
        const f32x4 s0 = *(const f32x4*)(sind + sq * 8), s1 = *(const f32x4*)(sind + sq * 8 + 4);
        const float cc[8] = {c0[0], c0[1], c0[2], c0[3], c1[0], c1[1], c1[2], c1[3]};
        const float ss[8] = {s0[0], s0[1], s0[2], s0[3], s1[0], s1[1], s1[2], s1[3]};
#pragma unroll
        for (int e = 0; e < 4; ++e) {
            const float x1l = h == 0 ? bf_lo(own[e]) : bf_lo(pw[e]), x1h = h == 0 ? bf_hi(own[e]) : bf_hi(pw[e]);
            const float x2l = h == 0 ? bf_lo(pw[e]) : bf_lo(own[e]), x2h = h == 0 ? bf_hi(pw[e]) : bf_hi(own[e]);
            const float yl = h == 0 ? (x1l * cc[2 * e] - x2l * ss[2 * e]) : (x1l * ss[2 * e] + x2l * cc[2 * e]);
            const float yh = h == 0 ? (x1h * cc[2 * e + 1] - x2h * ss[2 * e + 1]) : (x1h * ss[2 * e + 1] + x2h * cc[2 * e + 1]);
            res[e] = pk_bf16(yl, yh);
        }
        qf[0] = __builtin_bit_cast(bf16x8, res);
    }
    f32x16 sc[5];
    {
        bf16x8 kf[2][4];
        const int kbase = (wave * 32 + l32) * 144 + h * 16;
#pragma unroll
        for (int ks = 0; ks < 4; ++ks) kf[0][ks] = *(LAS bf16x8*)(lds + kbase + ks * 32);
#pragma unroll
        for (int kt = 0; kt < 5; ++kt) {
            if (kt < 4) {
#pragma unroll
                for (int ks = 0; ks < 4; ++ks) kf[(kt + 1) & 1][ks] = *(LAS bf16x8*)(lds + kbase + (kt + 1) * 32 * 144 + ks * 32);
            }
            SB();
#pragma unroll
            for (int i = 0; i < 16; ++i) sc[kt][i] = 0.f;
#pragma unroll
            for (int ks = 0; ks < 4; ++ks) sc[kt] = MFMA(kf[kt & 1][ks], qf[ks], sc[kt]);
            SB();
        }
    }
    const float cs = 0.125f * LOG2E;
    float mx = -1e30f;
    const int w0 = r0 + wave * 32;
    if (w0 - 64 >= 0 && w0 + 96 <= L) {
#pragma unroll
        for (int kt = 0; kt < 5; ++kt)
#pragma unroll
            for (int i = 0; i < 16; ++i) {
                const int cr = (i & 3) + 8 * (i >> 2) + 4 * h;
                const bool valid = (kt == 0) ? (cr >= l32) : (kt == 4) ? (cr <= l32) : true;
                const float v = valid ? sc[kt][i] * cs : -1e30f;
                sc[kt][i] = v; mx = fmaxf(mx, v);
            }
    } else {
#pragma unroll
        for (int kt = 0; kt < 5; ++kt)
#pragma unroll
            for (int i = 0; i < 16; ++i) {
                const int diff = -64 + 32 * kt + ((i & 3) + 8 * (i >> 2) + 4 * h) - l32;
                const int rk = rq + diff;
                const bool valid = (diff >= -64) && (diff <= 64) && (rk >= 0) && (rk < L);
                const float v = valid ? sc[kt][i] * cs : -1e30f;
                sc[kt][i] = v; mx = fmaxf(mx, v);
            }
    }
    mx = fmaxf(mx, __shfl_xor(mx, 32));
    float lsum = 0.f;
#pragma unroll
    for (int kt = 0; kt < 5; ++kt)
#pragma unroll
        for (int i = 0; i < 16; ++i) { const float e = __builtin_amdgcn_exp2f(sc[kt][i] - mx); sc[kt][i] = e; lsum += e; }
    lsum += __shfl_xor(lsum, 32);
    f32x16 o[2];
#pragma unroll
    for (int d = 0; d < 2; ++d)
#pragma unroll
        for (int i = 0; i < 16; ++i) o[d][i] = 0.f;
    const int q4 = (lane & 15) >> 2, p4 = lane & 3, blkk = (lane >> 4) & 1, xq = (q4 >> 1) & 1;
    int voff[2];
#pragma unroll
    for (int d = 0; d < 2; ++d) voff[d] = 55296 + (wave * 32 + 4 * h + q4) * 128 + ((4 * (d ^ xq) + 2 * blkk + (p4 >> 1)) << 4) + (p4 & 1) * 8;
    {
        s16x4 vlo[2][2][2], vhi[2][2][2];
#pragma unroll
        for (int s2 = 0; s2 < 2; ++s2)
#pragma unroll
            for (int d = 0; d < 2; ++d) {
                vlo[0][s2][d] = __builtin_amdgcn_ds_read_tr16_b64_v4i16((LAS s16x4*)(lds + voff[d] + (s2 * 16) * 128));
                vhi[0][s2][d] = __builtin_amdgcn_ds_read_tr16_b64_v4i16((LAS s16x4*)(lds + voff[d] + (s2 * 16 + 8) * 128));
            }
#pragma unroll
        for (int kt = 0; kt < 5; ++kt) {
            if (kt < 4) {
#pragma unroll
                for (int s2 = 0; s2 < 2; ++s2)
#pragma unroll
                    for (int d = 0; d < 2; ++d) {
                        vlo[(kt + 1) & 1][s2][d] = __builtin_amdgcn_ds_read_tr16_b64_v4i16((LAS s16x4*)(lds + voff[d] + ((kt + 1) * 32 + s2 * 16) * 128));
                        vhi[(kt + 1) & 1][s2][d] = __builtin_amdgcn_ds_read_tr16_b64_v4i16((LAS s16x4*)(lds + voff[d] + ((kt + 1) * 32 + s2 * 16 + 8) * 128));
                    }
            }
            SB();
#pragma unroll
            for (int s2 = 0; s2 < 2; ++s2) {
                u32x4 pw;
#pragma unroll
                for (int e = 0; e < 4; ++e) pw[e] = pk_bf16(sc[kt][8 * s2 + 2 * e], sc[kt][8 * s2 + 2 * e + 1]);
                const bf16x8 pf = __builtin_bit_cast(bf16x8, pw);
#pragma unroll
                for (int d = 0; d < 2; ++d) {
                    const bf16x8 vf = __builtin_shufflevector(vlo[kt & 1][s2][d], vhi[kt & 1][s2][d], 0, 1, 2, 3, 4, 5, 6, 7);
                    o[d] = MFMA(vf, pf, o[d]);
                }
            }
            SB();
        }
    }
    const float inv = __builtin_amdgcn_rcpf(lsum);
#pragma unroll
    for (int d = 0; d < 2; ++d)
#pragma unroll
        for (int gq = 0; gq < 4; ++gq) {
            u32x2 ov; ov[0] = pk_bf16(o[d][4 * gq] * inv, o[d][4 * gq + 1] * inv); ov[1] = pk_bf16(o[d][4 * gq + 2] * inv, o[d][4 * gq + 3] * inv);
            *(u32x2*)(qrow + d * 32 + 8 * gq + 4 * h) = ov;
        }
    if (h == 0) LSE[((size_t)g * T + (b * 8192 + sq)) * 8 + head] = mx + __builtin_amdgcn_logf(lsum);
    __syncthreads();
}

DI void mla_item(const Params& p, int b, int head, int qb, ldsp lds) {
    unsigned char* ws = p.ws;
    const bf16_t* P = (const bf16_t*)(ws + WS_P); const bf16_t* Q = (const bf16_t*)(ws + WS_Q);
    const bf16_t* KVb = (const bf16_t*)(ws + WS_KF) + (size_t)(b * 8192) * 1024 + head * 128;
    const bf16_t* KRb = (const bf16_t*)(ws + WS_KR) + (size_t)(b * 8192) * 32;
    bf16_t* MIX = (bf16_t*)(ws + WS_XB);
    const float* cosm = (const float*)(ws + WS_COSM); const float* sinm = (const float*)(ws + WS_SINM);
    const float* LSE = (const float*)(ws + WS_LSE);
    const int tid = tid_fresh(), wave = tid >> 6, lane = tid & 63, l32 = lane & 31, h = lane >> 5;
    const int sq = qb * 256 + wave * 32 + l32, tq = b * 8192 + sq;
    bf16x8 qf[6];
    {
        const float qs = 0.10206207261596575f * LOG2E;
        const bf16_t* qrow = Q + (size_t)tq * 768 + head * 96 + h * 8;
#pragma unroll
        for (int ks = 0; ks < 4; ++ks) {
            const u32x4 raw = *(const u32x4*)(qrow + ks * 16);
            u32x4 o;
#pragma unroll
            for (int e = 0; e < 4; ++e) o[e] = pk_bf16(bf_lo(raw[e]) * qs, bf_hi(raw[e]) * qs);
            qf[ks] = __builtin_bit_cast(bf16x8, o);
        }
        const u32x4 r1 = *(const u32x4*)(qrow + 64), r2 = *(const u32x4*)(qrow + 80);
        const f32x4 c0 = *(const f32x4*)(cosm + sq * 16 + h * 8), c1 = *(const f32x4*)(cosm + sq * 16 + h * 8 + 4);
        const f32x4 s0 = *(const f32x4*)(sinm + sq * 16 + h * 8), s1 = *(const f32x4*)(sinm + sq * 16 + h * 8 + 4);
        float x1[8], x2[8], cc[8], ss[8], y1[8], y2[8];
#pragma unroll
        for (int e = 0; e < 4; ++e) { x1[2 * e] = bf_lo(r1[e]); x1[2 * e + 1] = bf_hi(r1[e]); x2[2 * e] = bf_lo(r2[e]); x2[2 * e + 1] = bf_hi(r2[e]);
            cc[e] = c0[e]; cc[4 + e] = c1[e]; ss[e] = s0[e]; ss[4 + e] = s1[e]; }
#pragma unroll
        for (int e = 0; e < 8; ++e) { y1[e] = (x1[e] * cc[e] - x2[e] * ss[e]) * qs; y2[e] = (x1[e] * ss[e] + x2[e] * cc[e]) * qs; }
        u32x4 o1, o2;
#pragma unroll
        for (int e = 0; e < 4; ++e) { o1[e] = pk_bf16(y1[2 * e], y1[2 * e + 1]); o2[e] = pk_bf16(y2[2 * e], y2[2 * e + 1]); }
        qf[4] = __builtin_bit_cast(bf16x8, o1); qf[5] = __builtin_bit_cast(bf16x8, o2);
    }
    constexpr int STG = 20480;
    const unsigned lds_u = (unsigned)(size_t)lds;
    const bf16_t* gA; const bf16_t* gB; const bf16_t* gC; int strideA, strideB;
    {
        const int c = tid, row = c / 12, cl = (c % 12) ^ ((row >> 2) & 3);
        if (cl < 8) { gA = KVb + row * 1024 + cl * 8; strideA = 64 * 1024; } else { gA = KRb + row * 32 + (cl - 8) * 8; strideA = 64 * 32; }
    }
    if (tid < 256) {
        const int c = 512 + tid, row = c / 12, cl = (c % 12) ^ ((row >> 2) & 3);
        if (cl < 8) { gB = KVb + row * 1024 + cl * 8; strideB = 64 * 1024; } else { gB = KRb + row * 32 + (cl - 8) * 8; strideB = 64 * 32; }
    } else {
        const int c = tid - 256, row = c >> 3, cl = (c & 7) ^ (((row >> 1) & 1) << 2);
        gB = KVb + row * 1024 + 64 + cl * 8; strideB = 64 * 1024;
    }
    {
        const int c = 256 + (tid & 255), row = c >> 3, cl = (c & 7) ^ (((row >> 1) & 1) << 2);
        gC = KVb + row * 1024 + 64 + cl * 8;
    }
    const bool lowhalf = __builtin_amdgcn_readfirstlane(wave) < 4;
    const unsigned dA = (unsigned)__builtin_amdgcn_readfirstlane(wave) * 1024u;
    const unsigned dB = lowhalf ? (512u * 16u + (unsigned)__builtin_amdgcn_readfirstlane(wave) * 1024u) : (12288u + (unsigned)(__builtin_amdgcn_readfirstlane(wave) - 4) * 1024u);
    const unsigned dC = 12288u + 256u * 16u + (unsigned)(__builtin_amdgcn_readfirstlane(wave) & 3) * 1024u;
#define MLA_DMA(TILE, HSLOT) do {                                                                                   \
        const unsigned sb_ = lds_u + (unsigned)(HSLOT) * (unsigned)STG;                                             \
        glds16(gA + (size_t)(TILE) * strideA, (unsigned)__builtin_amdgcn_readfirstlane(sb_ + dA));                  \
        glds16(gB + (size_t)(TILE) * strideB, (unsigned)__builtin_amdgcn_readfirstlane(sb_ + dB));                  \
        if (lowhalf) glds16(gC + (size_t)(TILE) * (64 * 1024), (unsigned)__builtin_amdgcn_readfirstlane(sb_ + dC)); \
    } while (0)
#pragma unroll
    for (int i = 0; i < 4; ++i) MLA_DMA(i, i);
    asm volatile("s_waitcnt vmcnt(0) lgkmcnt(0)\n\ts_barrier" ::: "memory");
    f32x16 o[2];
#pragma unroll
    for (int d = 0; d < 2; ++d)
#pragma unroll
        for (int i = 0; i < 16; ++i) o[d][i] = 0.f;
    float m = -1e30f, mb = 0.f, lsum = 0.f;
    f32x16 negm;
#pragma unroll
    for (int i = 0; i < 16; ++i) negm[i] = 0.f;
    const int q4 = (lane & 15) >> 2, p4 = lane & 3, blkk = (lane >> 4) & 1, xq = (q4 >> 1) & 1;
    int voff[2];
#pragma unroll
    for (int d = 0; d < 2; ++d) voff[d] = 12288 + (4 * h + q4) * 128 + ((4 * (d ^ xq) + 2 * blkk + (p4 >> 1)) << 4) + (p4 & 1) * 8;
    int koffs[6];
#pragma unroll
    for (int ks = 0; ks < 6; ++ks) koffs[ks] = l32 * 192 + (((2 * ks + h) ^ ((l32 >> 2) & 3)) << 4);
    int hs = 0;
    auto qk_first = [&](f32x16 (&sc)[2], ldsp kb_base) {
#pragma unroll
        for (int kb = 0; kb < 2; ++kb) {
            sc[kb] = MFMA(*(LAS bf16x8*)(kb_base + koffs[0] + kb * 6144), qf[0], negm);
#pragma unroll
            for (int ks = 1; ks < 6; ++ks) sc[kb] = MFMA(*(LAS bf16x8*)(kb_base + koffs[ks] + kb * 6144), qf[ks], sc[kb]);
        }
    };
    auto step = [&](f32x16 (&cur)[2], float bs, f32x16 (&nxt)[2], float& bsn, ldsp kb_base, ldsp vb_base) {
        float mx = cur[0][0];
#pragma unroll
        for (int i = 1; i < 16; ++i) mx = fmaxf(mx, cur[0][i]);
#pragma unroll
        for (int i = 0; i < 16; ++i) mx = fmaxf(mx, cur[1][i]);
        { auto rr = __builtin_amdgcn_permlane32_swap(__float_as_uint(mx), __float_as_uint(mx), false, false);
          mx = fmaxf(__uint_as_float(rr[0]), __uint_as_float(rr[1])); }
        const float cand = bs + mx;
        const float mnew = (cand > m + 8.0f) ? cand : m;
        const float dl = mnew - bs;
        if (__builtin_amdgcn_ballot_w64((dl != 0.f) || (mnew > m)) != 0ull) {
#pragma unroll
            for (int kb = 0; kb < 2; ++kb)
#pragma unroll
                for (int i = 0; i < 16; ++i) cur[kb][i] -= dl;
            const float alpha = __builtin_amdgcn_exp2f(m - mnew);
#pragma unroll
            for (int d = 0; d < 2; ++d) o[d] = o[d] * alpha;
            lsum *= alpha; m = mnew; mb = mnew;
#pragma unroll
            for (int i = 0; i < 16; ++i) negm[i] = -mnew;
        }
        bsn = mb;
        bf16x8 kfa[6];
        s16x4 vlo[2][2], vhi[2][2];
#pragma unroll
        for (int ks = 0; ks < 6; ++ks) kfa[ks] = *(LAS bf16x8*)(kb_base + koffs[ks]);
#pragma unroll
        for (int s2 = 0; s2 < 2; ++s2)
#pragma unroll
            for (int d = 0; d < 2; ++d) {
                vlo[s2][d] = __builtin_amdgcn_ds_read_tr16_b64_v4i16((LAS s16x4*)(vb_base + voff[d] + (s2 * 16) * 128));
                vhi[s2][d] = __builtin_amdgcn_ds_read_tr16_b64_v4i16((LAS s16x4*)(vb_base + voff[d] + (s2 * 16 + 8) * 128));
            }
        bf16x8 kfb[6];
#pragma unroll
        for (int ks = 0; ks < 6; ++ks) kfb[ks] = *(LAS bf16x8*)(kb_base + koffs[ks] + 6144);
        SB();
        nxt[0] = MFMA(kfa[0], qf[0], negm);
#pragma unroll
        for (int ks = 1; ks < 6; ++ks) nxt[0] = MFMA(kfa[ks], qf[ks], nxt[0]);
#pragma unroll
        for (int i = 0; i < 16; ++i) { const float e = __builtin_amdgcn_exp2f(cur[0][i]); cur[0][i] = e; lsum += e; }
#pragma unroll
        for (int s2 = 0; s2 < 2; ++s2) {
            u32x4 pw;
#pragma unroll
            for (int e = 0; e < 4; ++e) pw[e] = pk_bf16(cur[0][8 * s2 + 2 * e], cur[0][8 * s2 + 2 * e + 1]);
            const bf16x8 pf = __builtin_bit_cast(bf16x8, pw);
#pragma unroll
            for (int d = 0; d < 2; ++d) o[d] = MFMA(__builtin_shufflevector(vlo[s2][d], vhi[s2][d], 0, 1, 2, 3, 4, 5, 6, 7), pf, o[d]);
        }
#pragma unroll
        for (int s2 = 0; s2 < 2; ++s2)
#pragma unroll
            for (int d = 0; d < 2; ++d) {
                vlo[s2][d] = __builtin_amdgcn_ds_read_tr16_b64_v4i16((LAS s16x4*)(vb_base + voff[d] + (32 + s2 * 16) * 128));
                vhi[s2][d] = __builtin_amdgcn_ds_read_tr16_b64_v4i16((LAS s16x4*)(vb_base + voff[d] + (32 + s2 * 16 + 8) * 128));
            }
        SB();
        nxt[1] = MFMA(kfb[0], qf[0], negm);
#pragma unroll
        for (int ks = 1; ks < 6; ++ks) nxt[1] = MFMA(kfb[ks], qf[ks], nxt[1]);
#pragma unroll
        for (int i = 0; i < 16; ++i) { const float e = __builtin_amdgcn_exp2f(cur[1][i]); cur[1][i] = e; lsum += e; }
#pragma unroll
        for (int s2 = 0; s2 < 2; ++s2) {
            u32x4 pw;
#pragma unroll
            for (int e = 0; e < 4; ++e) pw[e] = pk_bf16(cur[1][8 * s2 + 2 * e], cur[1][8 * s2 + 2 * e + 1]);
            const bf16x8 pf = __builtin_bit_cast(bf16x8, pw);
#pragma unroll
            for (int d = 0; d < 2; ++d) o[d] = MFMA(__builtin_shufflevector(vlo[s2][d], vhi[s2][d], 0, 1, 2, 3, 4, 5, 6, 7), pf, o[d]);
        }
    };
    f32x16 scA[2], scB[2];
    float bsA = mb, bsB = 0.f;
    qk_first(scA, lds);
#define MLA_STEP(CUR, BSCUR, NXT, BSNXT, TT, ODD) do {                                                              \
        const int t_ = (TT);                                                                                        \
        const int h1_ = (hs + 1 >= 6) ? hs + 1 - 6 : hs + 1, h4_ = (hs + 4 >= 6) ? hs + 4 - 6 : hs + 4;              \
        if (t_ + 4 < 128) MLA_DMA(t_ + 4, h4_);                                                                     \
        step(CUR, BSCUR, NXT, BSNXT, lds + h1_ * STG, lds + hs * STG);                                              \
        if (ODD) {                                                                                                  \
            if (t_ + 4 < 128) {                                                                                     \
                if (lowhalf) asm volatile("s_waitcnt vmcnt(3) lgkmcnt(0)\n\ts_barrier" ::: "memory");               \
                else asm volatile("s_waitcnt vmcnt(2) lgkmcnt(0)\n\ts_barrier" ::: "memory");                       \
            } else asm volatile("s_waitcnt vmcnt(0) lgkmcnt(0)\n\ts_barrier" ::: "memory");                         \
        }                                                                                                           \
        hs = h1_;                                                                                                   \
    } while (0)
    for (int kt = 0; kt < 128; kt += 2) {
        MLA_STEP(scA, bsA, scB, bsB, kt, false);
        MLA_STEP(scB, bsB, scA, bsA, kt + 1, true);
    }
#undef MLA_STEP
#undef MLA_DMA
    lsum += __shfl_xor(lsum, 32);
    const float inv = __builtin_amdgcn_rcpf(lsum);
    {
        const bf16_t* grow = P + (size_t)tq * INW + C_GA + head * 64;
        bf16_t* mrow = MIX + (size_t)tq * 1024 + head * 64;
#pragma unroll
        for (int d = 0; d < 2; ++d)
#pragma unroll
            for (int gq = 0; gq < 4; ++gq) {
                const int dd = d * 32 + 8 * gq + 4 * h;
                const u32x2 gt = *(const u32x2*)(grow + dd);
                u32x2 ov;
                ov[0] = pk_bf16(o[d][4 * gq] * inv * silu_f(bf_lo(gt[0])), o[d][4 * gq + 1] * inv * silu_f(bf_hi(gt[0])));
                ov[1] = pk_bf16(o[d][4 * gq + 2] * inv * silu_f(bf_lo(gt[1])), o[d][4 * gq + 3] * inv * silu_f(bf_hi(gt[1])));
                *(u32x2*)(mrow + dd) = ov;
            }
    }
    {
        const int tk = b * 8192 + qb * 256 + (tid >> 1), dh = (tid & 1) * 32;
        float l0 = LSE[((size_t)0 * T + tk) * 8 + head], l1 = LSE[((size_t)1 * T + tk) * 8 + head], l2 = LSE[((size_t)2 * T + tk) * 8 + head];
        const float lm = fmaxf(l0, fmaxf(l1, l2));
        float w0 = __builtin_amdgcn_exp2f(l0 - lm), w1 = __builtin_amdgcn_exp2f(l1 - lm), w2 = __builtin_amdgcn_exp2f(l2 - lm);
        const float wi = __builtin_amdgcn_rcpf(w0 + w1 + w2); w0 *= wi; w1 *= wi; w2 *= wi;
        const bf16_t* prow = P + (size_t)tk * INW;
        const bf16_t* o0 = prow + C_DQ + head * 64 + dh; const bf16_t* o1 = o0 + 1536; const bf16_t* o2 = o0 + 3072;
        const bf16_t* gb = prow + C_GB + head * 64 + dh;
        bf16_t* mrow = MIX + (size_t)tk * 1024 + 512 + head * 64 + dh;
#pragma unroll
        for (int c = 0; c < 4; ++c) {
            const u32x4 a0 = *(const u32x4*)(o0 + c * 8), a1 = *(const u32x4*)(o1 + c * 8), a2 = *(const u32x4*)(o2 + c * 8), gg = *(const u32x4*)(gb + c * 8);
            u32x4 ov;
#pragma unroll
            for (int e = 0; e < 4; ++e) {
                const float vlo = (w0 * bf_lo(a0[e]) + w1 * bf_lo(a1[e]) + w2 * bf_lo(a2[e])) * silu_f(bf_lo(gg[e]));
                const float vhi = (w0 * bf_hi(a0[e]) + w1 * bf_hi(a1[e]) + w2 * bf_hi(a2[e])) * silu_f(bf_hi(gg[e]));
                ov[e] = pk_bf16(vlo, vhi);
            }
            *(u32x4*)(mrow + c * 8) = ov;
        }
    }
}

__global__ void __launch_bounds__(512) hymba_fwd(Params p_arg) {
    extern __shared__ __attribute__((aligned(16))) unsigned char smem_raw[];
    __shared__ u32x4 xb_words;
    ldsp lds = (ldsp)smem_raw;
    if (threadIdx.x == 0) xb_words = (u32x4){0u, 0u, 0u, 0u};
    __syncthreads();
    XcdBarrier bar;
    { const Params& p = load_params(); bar = xcd_barrier_post((unsigned*)(p.ws + WS_BAR), (volatile LAS unsigned*)&xb_words); }
    { const Params& p = load_params(); prologue_phase(p, lds); }
    {
        const Params& p = load_params(); float* ssq = (float*)(p.ws + WS_SSQ);
        for (int i = bid_fresh() * 512 + tid_fresh(); i < (NLAYER - 1) * T; i += gridDim.x * 512) ssq[T + i] = 0.f;
        float* ssql = (float*)(p.ws + WS_SSQL);
        for (int i = bid_fresh() * 512 + tid_fresh(); i < NLAYER * 2 * T; i += gridDim.x * 512) ssql[i] = 0.f;
        norm_phase(p.x, (bf16_t*)(p.ws + WS_XB2), ssq);
    }
    cg::this_grid().sync();
    int vb, vc;
    {
        const Params& p = load_params(); unsigned* barw = (unsigned*)(p.ws + WS_BAR);
        bool ok = (gridDim.x == 256);
#pragma unroll
        for (unsigned j = 0; j < 16; ++j) { const unsigned c = xb_ld(&barw[XB_XCNT(j)]); ok = ok && (c == (j < 8 ? 32u : 0u)); }
        const unsigned rank = ((volatile LAS unsigned*)&xb_words)[2];
        vb = ok ? (int)(bar.x * 32u + rank) : (int)blockIdx.x;
        vb = __builtin_amdgcn_readfirstlane(vb);
        vc = ok ? (int)(rank * 8u + bar.x) : (int)blockIdx.x;
        vc = __builtin_amdgcn_readfirstlane(vc);
    }

    for (int l = 0; l < NLAYER; ++l) {
        {
            const Params& p = load_params(); unsigned char* ws = p.ws;
            const bf16_t* W = (const bf16_t*)(ws + WS_WIN) + (size_t)l * INWP * 1024;
            EpiRowScaleBf16 epi{(bf16_t*)(ws + WS_P), INW, (const float*)(ws + WS_RSTD), INW};
            pg8::StaticOrder so; so.init(T, INWP, (int)gridDim.x, vb_fresh(vc));
            pg8::Gemm g{(const bf16_t*)(ws + WS_XB2), W, T, INWP, 1024};
            EpiInproj e2{(bf16_t*)(ws + WS_P), (const float*)(ws + WS_SSQ) + (size_t)l * T, (bf16_t*)(ws + WS_CQ), (bf16_t*)(ws + WS_CKV),
                         (float*)(ws + WS_SSQL) + (size_t)(2 * l) * T, (float*)(ws + WS_SSQL) + (size_t)(2 * l + 1) * T, (bf16_t*)(ws + WS_KR),
                         (const float*)(ws + WS_COSM), (const float*)(ws + WS_SINM)};
            (void)epi;
            pg8::gemm_phase<EpiInproj, pg8::StaticOrder, true, true>(lds, g, so, e2);
            if (l + 1 < NLAYER) {
                const int id = vb_fresh(vc), G = (int)gridDim.x;
                if (G == 256) { if (id >= 64) convert_weights(p, lds, (l + 1) * TILES_PER_LAYER, (l + 2) * TILES_PER_LAYER, id - 64, 192); }
                else convert_weights(p, lds, (l + 1) * TILES_PER_LAYER, (l + 2) * TILES_PER_LAYER, id, G);
            }
        }
        xcd_barrier(bar);
        {
            const Params& p = load_params(); unsigned char* ws = p.ws;
            const bf16_t* Wq = (const bf16_t*)(ws + WS_WUQ) + (size_t)l * 768 * 384;
            const bf16_t* Wkv = (const bf16_t*)(ws + WS_WUKV) + (size_t)l * 1024 * 256;
            {
                pg8::StaticOrder so; so.init(T, 768, (int)gridDim.x, vb_fresh(vc));
                pg8::Gemm g{(const bf16_t*)(ws + WS_CQ), Wq, T, 768, 384};
                EpiUpRow eq{(bf16_t*)(ws + WS_Q), (const float*)(ws + WS_SSQL) + (size_t)(2 * l) * T, 768, 1.0f / 384.0f};
                pg8::gemm_phase<EpiUpRow, pg8::StaticOrder, false, true>(lds, g, so, eq);
            }
            {
                pg8::StaticOrder so; so.init(T, 1024, (int)gridDim.x, vb_fresh(vc));
                pg8::Gemm g{(const bf16_t*)(ws + WS_CKV), Wkv, T, 1024, 256};
                EpiUpRow ekv{(bf16_t*)(ws + WS_KF), (const float*)(ws + WS_SSQL) + (size_t)(2 * l + 1) * T, 1024, 1.0f / 256.0f};
                pg8::gemm_phase<EpiUpRow, pg8::StaticOrder, false, true>(lds, g, so, ekv);
            }
        }
        {
            const Params& p = load_params();
            for (int it = bid_fresh(); it < 1536; it += gridDim.x) dil_item(p, it, lds);
        }
        xcd_barrier(bar);
        {
            const Params& p = load_params();
            for (int it = vb_fresh(vb); it < 512; it += gridDim.x) mla_item(p, it >> 8, (it >> 5) & 7, it & 31, lds);
        }
        xcd_barrier(bar);
        {
            const Params& p = load_params(); unsigned char* ws = p.ws;
            const bf16_t* Wo = (const bf16_t*)(ws + WS_WOUT) + (size_t)l * 1024 * 1024;
            EpiResid eo{p.out, l == 0 ? p.x : (const float*)p.out};
            pg8::StaticOrder so; so.init(T, 1024, (int)gridDim.x, vb_fresh(vc));
            pg8::Gemm g{(const bf16_t*)(ws + WS_XB), Wo, T, 1024, 1024};
            EpiOutRes e2{p.out, l == 0 ? p.x : (const float*)p.out, (bf16_t*)(ws + WS_XB2), (l + 1 < NLAYER) ? (float*)(ws + WS_SSQ) + (size_t)(l + 1) * T : nullptr};
            (void)eo;
            pg8::gemm_phase<EpiOutRes, pg8::StaticOrder, false, true>(lds, g, so, e2);
        }
        xcd_barrier(bar);
    }
    { const Params& p = load_params(); final_phase(p.out, p.final_g); }
}

extern "C" void kernel_launch(void* const* d_in, const int* in_sizes, int n_in, void* d_out, int out_size, void* d_ws, size_t ws_size, hipStream_t stream) {
    static int grid_blocks = 0;
    if (!grid_blocks) {
        if (n_in != 9 || in_sizes[0] != T * DM || out_size != T * DM || ws_size < WS_END2) {
            fprintf(stderr, "kernel_launch: unexpected shapes (n_in %d, in0 %d, out %d, ws %zu need %zu)\n", n_in, n_in > 0 ? in_sizes[0] : -1, out_size, ws_size, (size_t)WS_END2);
            grid_blocks = -1; return;
        }
        int dev = 0, cus = 0, per_cu = 0;
        (void)hipGetDevice(&dev);
        (void)hipDeviceGetAttribute(&cus, hipDeviceAttributeMultiprocessorCount, dev);
        if (hipFuncSetAttribute((const void*)hymba_fwd, hipFuncAttributeMaxDynamicSharedMemorySize, LDS_BYTES) != hipSuccess) { fprintf(stderr, "kernel_launch: hipFuncSetAttribute failed\n"); grid_blocks = -1; return; }
        (void)hipOccupancyMaxActiveBlocksPerMultiprocessor(&per_cu, (const void*)hymba_fwd, 512, LDS_BYTES);
        if (per_cu < 1) { fprintf(stderr, "kernel_launch: occupancy query says 0 blocks per CU\n"); grid_blocks = -1; return; }
        grid_blocks = cus;
    }
    if (grid_blocks < 0) return;
    (void)hipMemsetAsync((unsigned char*)d_ws + WS_BAR, 0, 16384, stream);
    Params p{};
    p.x = (const float*)d_in[0]; p.norm_g = (const float*)d_in[1]; p.w_in = (const float*)d_in[2]; p.q_norm_g = (const float*)d_in[3];
    p.kv_norm_g = (const float*)d_in[4]; p.w_uq = (const float*)d_in[5]; p.w_ukv = (const float*)d_in[6]; p.w_out = (const float*)d_in[7];
    p.final_g = (const float*)d_in[8]; p.out = (float*)d_out; p.ws = (unsigned char*)d_ws;
    for (int i = 0; i < 16; ++i) { const float e = (2.0f * (float)i) / 32.0f; p.inv_m[i] = 1.0f / powf(500000.0f, e); }
    for (int i = 0; i < 8; ++i) { const float e = (2.0f * (float)i) / 16.0f; p.inv_d[i] = 1.0f / powf(500000.0f, e); }
    void* args[] = {&p};
    hipError_t e = hipLaunchCooperativeKernel((const void*)hymba_fwd, dim3(grid_blocks), dim3(512), args, LDS_BYTES, stream);
    if (e != hipSuccess) fprintf(stderr, "kernel_launch: cooperative launch failed: %s (grid %d)\n", hipGetErrorString(e), grid_blocks);
}
```

```cpp
#include <hip/hip_runtime.h>
#include <hip/hip_cooperative_groups.h>
#include <cstdio>
#include <cstdint>
#include <cmath>
namespace cg = cooperative_groups;

#define DI __device__ __forceinline__
#define LAS __attribute__((address_space(3)))
typedef unsigned short bf16_t;
typedef short bf16x8 __attribute__((ext_vector_type(8)));
typedef short s16x4 __attribute__((ext_vector_type(4)));
typedef float f32x16 __attribute__((ext_vector_type(16)));
typedef float f32x4 __attribute__((ext_vector_type(4)));
typedef float f32x2 __attribute__((ext_vector_type(2)));
typedef unsigned u32x4 __attribute__((ext_vector_type(4)));
typedef unsigned u32x2 __attribute__((ext_vector_type(2)));
typedef __bf16 bf16x2_t __attribute__((ext_vector_type(2)));
typedef LAS unsigned char* ldsp;
#define MFMA(a, b, c) __builtin_amdgcn_mfma_f32_32x32x16_bf16((a), (b), (c), 0, 0, 0)
#define SB() __builtin_amdgcn_sched_barrier(0)

constexpr int T = 16384, S = 8192, DM = 1024, INW = 6304, INWP = 6400, NLAYER = 4;
constexpr int C_CQ = 0, C_CKV = 384, C_KR = 640, C_GA = 672, C_DQ = 1184, C_GB = 5792;
constexpr float LOG2E = 1.4426950408889634f;
constexpr float EPSN = 1e-6f;

constexpr size_t al256(size_t x) { return (x + 255) & ~(size_t)255; }
constexpr size_t WS_BAR = 0;
constexpr size_t WS_WIN = 16384;
constexpr size_t WS_WUQ = WS_WIN + (size_t)NLAYER * INWP * 1024 * 2;
constexpr size_t WS_WUKV = WS_WUQ + (size_t)NLAYER * 768 * 384 * 2;
constexpr size_t WS_WOUT = WS_WUKV + (size_t)NLAYER * 1024 * 256 * 2;
constexpr size_t WS_COSM = WS_WOUT + (size_t)NLAYER * 1024 * 1024 * 2;
constexpr size_t WS_SINM = WS_COSM + (size_t)S * 16 * 4;
constexpr size_t WS_COSD = WS_SINM + (size_t)S * 16 * 4;
constexpr size_t WS_SIND = WS_COSD + (size_t)S * 8 * 4;
constexpr size_t WS_RSTD = WS_SIND + (size_t)S * 8 * 4;
constexpr size_t WS_RSTDQ = WS_RSTD + (size_t)T * 4;
constexpr size_t WS_RSTDKV = WS_RSTDQ + (size_t)T * 4;
constexpr size_t WS_LSE = WS_RSTDKV + (size_t)T * 4;
constexpr size_t WS_SSQ = WS_LSE + (size_t)3 * T * 8 * 4;
constexpr size_t WS_XB = WS_SSQ + (size_t)NLAYER * T * 4;
constexpr size_t WS_P = WS_XB + (size_t)T * 1024 * 2;
constexpr size_t WS_Q = WS_P + (size_t)T * INW * 2;
constexpr size_t WS_KF = WS_Q + (size_t)T * 768 * 2;
constexpr size_t WS_V = WS_KF + (size_t)T * 8 * 96 * 2;
constexpr size_t WS_END = WS_V + (size_t)T * 8 * 64 * 2;
constexpr size_t WS_CQ = WS_END;
constexpr size_t WS_CKV = WS_CQ + (size_t)T * 384 * 2;
constexpr size_t WS_KR = WS_CKV + (size_t)T * 256 * 2;
constexpr size_t WS_SSQL = WS_KR + (size_t)T * 32 * 2;
constexpr size_t WS_END2 = WS_SSQL + (size_t)NLAYER * 2 * T * 4;
static_assert(WS_END - WS_KF >= (size_t)T * 1024 * 2, "KVB must fit the KF|V region");
constexpr size_t WS_XB2 = WS_Q;
static_assert(WS_KF + (size_t)T * 8 * 96 * 2 - WS_Q >= (size_t)T * 1024 * 2, "XB2 overlay too small");

constexpr int LDS_BYTES = 147456;

struct Params {
    const float* x; const float* norm_g; const float* w_in; const float* q_norm_g; const float* kv_norm_g;
    const float* w_uq; const float* w_ukv; const float* w_out; const float* final_g;
    float* out; unsigned char* ws;
    float inv_m[16]; float inv_d[8];
};

__device__ __forceinline__ const Params& load_params() {
    auto kp = (const __attribute__((address_space(4))) Params*)__builtin_amdgcn_kernarg_segment_ptr();
    asm volatile("" : "+s"(kp));
    return *(const Params*)kp;
}
DI int tid_fresh() { int t = threadIdx.x; asm volatile("" : "+v"(t)); return t; }
DI int vb_fresh(int v) { asm volatile("" : "+s"(v)); return v; }
DI int bid_fresh() { int b = blockIdx.x; asm volatile("" : "+s"(b)); return b; }
DI unsigned pk_bf16(float lo, float hi) { f32x2 v = {lo, hi}; return __builtin_bit_cast(unsigned, __builtin_convertvector(v, bf16x2_t)); }
DI float bf_lo(unsigned u) { return __uint_as_float(u << 16); }
DI float bf_hi(unsigned u) { return __uint_as_float(u & 0xffff0000u); }
DI float wave_sum(float v) {
#pragma unroll
    for (int o = 32; o > 0; o >>= 1) v += __shfl_xor(v, o);
    return v;
}
DI void glds16(const void* gsrc, unsigned lds_dst) { unsigned keep;
    asm volatile("s_mov_b32 %0, m0\n\ts_mov_b32 m0, %2\n\ts_nop 0\n\tglobal_load_lds_dwordx4 %1, off\n\ts_mov_b32 m0, %0" : "=&s"(keep) : "v"(gsrc), "s"(lds_dst) : "memory"); }
DI float silu_f(float x) { return x * __builtin_amdgcn_rcpf(1.0f + __builtin_amdgcn_exp2f(-x * LOG2E)); }

#define XB_TMO      128
#define XB_XCNT(j)  (256  + 64 * (j))
#define XB_XSUB(j)  (1280 + 64 * (j))
#define XB_XGEN(j)  (2304 + 64 * (j))
#define XB_TOP      3328
#define XB_TOPGEN   3392
#define XCD_BAR_WORDS 3456
#define XB_SPIN_CAP (1u << 22)
DI unsigned xb_ld(unsigned* p)              { return __hip_atomic_load(p, __ATOMIC_RELAXED, __HIP_MEMORY_SCOPE_AGENT); }
DI unsigned xb_add(unsigned* p, unsigned v) { return __hip_atomic_fetch_add(p, v, __ATOMIC_RELAXED, __HIP_MEMORY_SCOPE_AGENT); }
DI unsigned xb_xcc_id() { return (unsigned)__builtin_amdgcn_s_getreg((3 << 11) | 20) & 0xFu; }
#define XB_SPIN(cond, bar) do { unsigned _sp = 0; while (cond) { __builtin_amdgcn_s_sleep(1); \
    if ((++_sp & 255u) == 0u) { if (xb_ld(&(bar)[XB_TMO])) break; if (_sp > XB_SPIN_CAP) { atomicAdd(&(bar)[XB_TMO], 1u); break; } } } } while (0)
struct XcdBarrier { unsigned* bar; unsigned x; volatile LAS unsigned* st; };
DI XcdBarrier xcd_barrier_post(unsigned* bar, volatile LAS unsigned* st) {
    XcdBarrier b; b.bar = bar; b.x = xb_xcc_id(); b.st = st;
    if (threadIdx.x == 0) st[2] = xb_add(&bar[XB_XCNT(b.x)], 1u);
    return b;
}
DI void xcd_barrier_complete(unsigned* bar, unsigned x, unsigned& nloc, unsigned& nx) {
    const unsigned G = gridDim.x * gridDim.y * gridDim.z;
    unsigned sum, cnt, mine, sp = 0u;
    for (;;) {
        sum = 0u; cnt = 0u; mine = 0u;
#pragma unroll
        for (unsigned j = 0; j < 16; ++j) { const unsigned c = xb_ld(&bar[XB_XCNT(j)]); sum += c; cnt += (c > 0u) ? 1u : 0u; mine = (j == x) ? c : mine; }
        if (sum == G) break;
        __builtin_amdgcn_s_sleep(1);
        if ((++sp & 255u) == 0u) { if (xb_ld(&bar[XB_TMO])) break; if (sp > XB_SPIN_CAP) { atomicAdd(&bar[XB_TMO], 1u); break; } }
    }
    nloc = mine > 0u ? mine : 1u; nx = cnt > 0u ? cnt : 1u;
}
DI void xcd_barrier(const XcdBarrier& b) {
    asm volatile("s_waitcnt vmcnt(0)" ::: "memory");
    __syncthreads();
    if (threadIdx.x == 0) {
        unsigned* bar = b.bar;
        __builtin_amdgcn_s_waitcnt(0);
        unsigned nloc = b.st[0], nx = b.st[1];
        if (nloc == 0u) { xcd_barrier_complete(bar, b.x, nloc, nx); b.st[0] = nloc; b.st[1] = nx; }
        const unsigned old = xb_add(&bar[XB_XSUB(b.x)], 1u);
        const unsigned gen = old / nloc;
        if (old + 1u == (gen + 1u) * nloc) {
            __builtin_amdgcn_fence(__ATOMIC_RELEASE, "agent");
            asm volatile("s_waitcnt vmcnt(0)" ::: "memory");
            const unsigned og = xb_add(&bar[XB_TOP], 1u);
            const unsigned tg = og / nx;
            if (og + 1u == (tg + 1u) * nx) xb_add(&bar[XB_TOPGEN], 1u);
            else XB_SPIN(xb_ld(&bar[XB_TOPGEN]) == tg, bar);
            __builtin_amdgcn_fence(__ATOMIC_ACQUIRE, "agent");
            xb_add(&bar[XB_XGEN(b.x)], 1u);
            asm volatile("s_waitcnt vmcnt(0)" ::: "memory");
        } else {
            XB_SPIN(xb_ld(&bar[XB_XGEN(b.x)]) == gen, bar);
            __builtin_amdgcn_fence(__ATOMIC_ACQUIRE, "agent");
            asm volatile("s_waitcnt vmcnt(0)" ::: "memory");
        }
    }
    __syncthreads();
}

struct TTile { const float* src; const float* gain; bf16_t* dst; int K, N, k0, n0; };
DI TTile tt_decode(const Params& p, int u) {
    constexpr int TIN = 16 * 100, TUQ = 6 * 12, TUKV = 4 * 16, TOUT = 16 * 16, TL = TIN + TUQ + TUKV + TOUT;
    unsigned char* ws = p.ws;
    const int l = u / TL; int r = u % TL; TTile t;
    if (r < TIN) { t.src = p.w_in + (size_t)l * 1024 * INW; t.gain = p.norm_g + l * 1024; t.dst = (bf16_t*)(ws + WS_WIN) + (size_t)l * INWP * 1024; t.K = 1024; t.N = INW; t.k0 = (r / 100) * 64; t.n0 = (r % 100) * 64; }
    else if ((r -= TIN) < TUQ) { t.src = p.w_uq + (size_t)l * 384 * 768; t.gain = p.q_norm_g + l * 384; t.dst = (bf16_t*)(ws + WS_WUQ) + (size_t)l * 768 * 384; t.K = 384; t.N = 768; t.k0 = (r / 12) * 64; t.n0 = (r % 12) * 64; }
    else if ((r -= TUQ) < TUKV) { t.src = p.w_ukv + (size_t)l * 256 * 1024; t.gain = p.kv_norm_g + l * 256; t.dst = (bf16_t*)(ws + WS_WUKV) + (size_t)l * 1024 * 256; t.K = 256; t.N = 1024; t.k0 = (r / 16) * 64; t.n0 = (r % 16) * 64; }
    else { r -= TUKV; t.src = p.w_out + (size_t)l * 1024 * 1024; t.gain = nullptr; t.dst = (bf16_t*)(ws + WS_WOUT) + (size_t)l * 1024 * 1024; t.K = 1024; t.N = 1024; t.k0 = (r / 16) * 64; t.n0 = (r % 16) * 64; }
    return t;
}

constexpr int TILES_PER_LAYER = 16 * 100 + 6 * 12 + 4 * 16 + 16 * 16;
DI void convert_weights(const Params& p, ldsp lds, int ubeg, int uend, int wg, int nwg) {
    const int tid = tid_fresh();
    const int G = nwg, TOTAL = uend;
    for (int u0 = ubeg + wg; u0 < TOTAL; u0 += 4 * G) {
        float v[4][8];
#pragma unroll
        for (int g = 0; g < 4; ++g)
#pragma unroll
            for (int i = 0; i < 8; ++i) v[g][i] = 0.f;
#pragma unroll
        for (int g = 0; g < 4; ++g) {
            const int u = u0 + g * G;
            if (u < TOTAL) {
                const TTile t = tt_decode(p, u);
#pragma unroll
                for (int i = 0; i < 8; ++i) {
                    const int idx = tid + 512 * i, k = idx >> 6, n = idx & 63;
                    float x = 0.f;
                    if (t.n0 + n < t.N) x = t.src[(size_t)(t.k0 + k) * t.N + t.n0 + n];
                    if (t.gain) x *= t.gain[t.k0 + k];
                    v[g][i] = x;
                }
            }
        }
#pragma unroll
        for (int g = 0; g < 4; ++g) {
            LAS float* tile = (LAS float*)(lds + g * 16640);
#pragma unroll
            for (int i = 0; i < 8; ++i) { const int idx = tid + 512 * i; tile[(idx >> 6) * 65 + (idx & 63)] = v[g][i]; }
        }
        __syncthreads();
#pragma unroll
        for (int g = 0; g < 4; ++g) {
            const int u = u0 + g * G;
            if (u < TOTAL) {
                const TTile t = tt_decode(p, u);
                LAS float* tile = (LAS float*)(lds + g * 16640);
#pragma unroll
                for (int i = 0; i < 4; ++i) {
                    const int idx = tid + 512 * i, n = idx >> 5, k2 = idx & 31;
                    const unsigned w = pk_bf16(tile[(2 * k2) * 65 + n], tile[(2 * k2 + 1) * 65 + n]);
                    *(unsigned*)(t.dst + (size_t)(t.n0 + n) * t.K + t.k0 + 2 * k2) = w;
                }
            }
        }
        __syncthreads();
    }
}

DI void prologue_phase(const Params& p, ldsp lds) {
    unsigned char* ws = p.ws;
    convert_weights(p, lds, 0, TILES_PER_LAYER, bid_fresh(), (int)gridDim.x);
    float* cosm = (float*)(ws + WS_COSM); float* sinm = (float*)(ws + WS_SINM);
    float* cosd = (float*)(ws + WS_COSD); float* sind = (float*)(ws + WS_SIND);
    const int gt = bid_fresh() * 512 + tid_fresh(), gn = gridDim.x * 512;
    for (int i = gt; i < S * 16; i += gn) {
        const int pos = i >> 4, f = i & 15;
        const float ang = (float)pos * p.inv_m[f];
        const double rev = (double)ang * 0.15915494309189535;
        const float fr = (float)(rev - floor(rev));
        cosm[i] = __builtin_amdgcn_cosf(fr); sinm[i] = __builtin_amdgcn_sinf(fr);
    }
    for (int i = gt; i < S * 8; i += gn) {
        const int pos = i >> 3, f = i & 7;
        const float ang = (float)pos * p.inv_d[f];
        const double rev = (double)ang * 0.15915494309189535;
        const float fr = (float)(rev - floor(rev));
        cosd[i] = __builtin_amdgcn_cosf(fr); sind[i] = __builtin_amdgcn_sinf(fr);
    }
}

DI void norm_phase(const float* __restrict__ x, bf16_t* __restrict__ xb, float* __restrict__ rstd) {
    const int tid = tid_fresh(), wave = tid >> 6, lane = tid & 63;
    for (int row = bid_fresh() * 8 + wave; row < T; row += gridDim.x * 8) {
        const f32x4* xr = (const f32x4*)(x + (size_t)row * 1024);
        f32x4 v[4]; float ss = 0.f;
#pragma unroll
        for (int j = 0; j < 4; ++j) { v[j] = xr[lane + 64 * j]; ss += v[j][0] * v[j][0] + v[j][1] * v[j][1] + v[j][2] * v[j][2] + v[j][3] * v[j][3]; }
        ss = wave_sum(ss);
        if (lane == 0) rstd[row] = ss;
#pragma unroll
        for (int j = 0; j < 4; ++j) {
            u32x2 o; o[0] = pk_bf16(v[j][0], v[j][1]); o[1] = pk_bf16(v[j][2], v[j][3]);
            *(u32x2*)(xb + (size_t)row * 1024 + (lane + 64 * j) * 4) = o;
        }
    }
}

DI void final_phase(float* __restrict__ out, const float* __restrict__ g) {
    const int tid = tid_fresh(), wave = tid >> 6, lane = tid & 63;
    for (int row = bid_fresh() * 8 + wave; row < T; row += gridDim.x * 8) {
        f32x4* xr = (f32x4*)(out + (size_t)row * 1024);
        f32x4 v[4]; float ss = 0.f;
#pragma unroll
        for (int j = 0; j < 4; ++j) { v[j] = xr[lane + 64 * j]; ss += v[j][0] * v[j][0] + v[j][1] * v[j][1] + v[j][2] * v[j][2] + v[j][3] * v[j][3]; }
        ss = wave_sum(ss);
        const float rs = __builtin_amdgcn_rsqf(ss * (1.0f / 1024.0f) + EPSN);
#pragma unroll
        for (int j = 0; j < 4; ++j) {
            const f32x4 gg = ((const f32x4*)g)[lane + 64 * j];
            xr[lane + 64 * j] = v[j] * rs * gg;
        }
    }
}

#define GAS __attribute__((address_space(1)))
template <class Epi>
DI void gemm_tile(const bf16_t* __restrict__ W, const bf16_t* __restrict__ A, int lda, int K, int n0, int t0, ldsp lds, const Epi& epi) {
    const int tid = tid_fresh(), wave = tid >> 6, lane = tid & 63, l32 = lane & 31, h = lane >> 5;
    const int wr = wave >> 2, wc = wave & 3;
    const int lrow = tid >> 3, pc = tid & 7, lc = pc ^ ((lrow >> 1) & 7);
    f32x16 acc[4][2];
#pragma unroll
    for (int ni = 0; ni < 4; ++ni)
#pragma unroll
        for (int ti = 0; ti < 2; ++ti)
#pragma unroll
            for (int i = 0; i < 16; ++i) acc[ni][ti][i] = 0.f;
    const bf16_t* wp = W + (size_t)(n0 + lrow) * K + lc * 8;
    const bf16_t* ap = A + (size_t)(t0 + lrow) * lda + lc * 8;
    const int dst = tid * 16;
#define GEMM_DMA(ST, KO) do {                                                                                                       \
        _Pragma("unroll") for (int i_ = 0; i_ < 4; ++i_) {                                                                          \
            __builtin_amdgcn_global_load_lds((const GAS void*)(wp + (size_t)(64 * i_) * K + (KO)), (LAS void*)((ST) + dst + i_ * 8192), 16, 0, 0);           \
            __builtin_amdgcn_global_load_lds((const GAS void*)(ap + (size_t)(64 * i_) * lda + (KO)), (LAS void*)((ST) + 32768 + dst + i_ * 8192), 16, 0, 0); \
        } } while (0)
    GEMM_DMA(lds, 0);
    asm volatile("s_waitcnt vmcnt(0)" ::: "memory");
    __syncthreads();
    const int nk = K >> 6;
    const int swz = (l32 >> 1) & 7;
    const int arow = (wr * 128 + l32) * 128, brow = 32768 + (wc * 64 + l32) * 128;
    int coff[4];
#pragma unroll
    for (int ks = 0; ks < 4; ++ks) coff[ks] = ((2 * ks + h) ^ swz) << 4;
    for (int kt = 0; kt < nk; ++kt) {
        ldsp cur = lds + (kt & 1) * 65536;
        if (kt + 1 < nk) { ldsp nxt = lds + ((kt + 1) & 1) * 65536; GEMM_DMA(nxt, (kt + 1) * 64); }
        {
            bf16x8 af[2][4], bfr[2][2];
#pragma unroll
            for (int ni = 0; ni < 4; ++ni) af[0][ni] = *(LAS bf16x8*)(cur + arow + ni * 4096 + coff[0]);
#pragma unroll
            for (int ti = 0; ti < 2; ++ti) bfr[0][ti] = *(LAS bf16x8*)(cur + brow + ti * 4096 + coff[0]);
#pragma unroll
            for (int ks = 0; ks < 4; ++ks) {
                if (ks < 3) {
#pragma unroll
                    for (int ni = 0; ni < 4; ++ni) af[(ks + 1) & 1][ni] = *(LAS bf16x8*)(cur + arow + ni * 4096 + coff[(ks + 1) & 3]);
#pragma unroll
                    for (int ti = 0; ti < 2; ++ti) bfr[(ks + 1) & 1][ti] = *(LAS bf16x8*)(cur + brow + ti * 4096 + coff[(ks + 1) & 3]);
                }
                SB();
#pragma unroll
                for (int ni = 0; ni < 4; ++ni)
#pragma unroll
                    for (int ti = 0; ti < 2; ++ti) acc[ni][ti] = MFMA(af[ks & 1][ni], bfr[ks & 1][ti], acc[ni][ti]);
                SB();
            }
        }
        asm volatile("s_waitcnt vmcnt(0)" ::: "memory");
        __syncthreads();
    }
#undef GEMM_DMA
    epi(acc, n0 + wr * 128, t0 + wc * 64, l32, h);
}

struct EpiRowScaleBf16 {
    bf16_t* O; int ld; const float* rs; int nmax;
    DI void operator()(const f32x16 (&acc)[4][2], int nb, int tb, int l32, int h) const {
#pragma unroll
        for (int ti = 0; ti < 2; ++ti) {
            const int t = tb + ti * 32 + l32; const float r = rs[t]; bf16_t* row = O + (size_t)t * ld;
#pragma unroll
            for (int ni = 0; ni < 4; ++ni)
#pragma unroll
                for (int g = 0; g < 4; ++g) {
                    const int n = nb + ni * 32 + 8 * g + 4 * h;
                    if (n < nmax) { u32x2 o; o[0] = pk_bf16(acc[ni][ti][4 * g] * r, acc[ni][ti][4 * g + 1] * r); o[1] = pk_bf16(acc[ni][ti][4 * g + 2] * r, acc[ni][ti][4 * g + 3] * r);
                        *(u32x2*)(row + n) = o; }
                }
        }
    }
};
struct EpiKV {
    bf16_t* KF; bf16_t* V; const float* rs;
    DI void operator()(const f32x16 (&acc)[4][2], int nb, int tb, int l32, int h) const {
#pragma unroll
        for (int ti = 0; ti < 2; ++ti) {
            const int t = tb + ti * 32 + l32; const float r = rs[t]; const int b = t >> 13, s = t & 8191;
#pragma unroll
            for (int ni = 0; ni < 4; ++ni)
#pragma unroll
                for (int g = 0; g < 4; ++g) {
                    const int n = nb + ni * 32 + 8 * g + 4 * h; const int head = n >> 7, w = n & 127;
                    u32x2 o; o[0] = pk_bf16(acc[ni][ti][4 * g] * r, acc[ni][ti][4 * g + 1] * r); o[1] = pk_bf16(acc[ni][ti][4 * g + 2] * r, acc[ni][ti][4 * g + 3] * r);
                    const size_t rowi = (size_t)(b * 8 + head) * 8192 + s;
                    bf16_t* dst = (w < 64) ? (KF + rowi * 96 + w) : (V + rowi * 64 + (w - 64));
                    *(u32x2*)dst = o;
                }
        }
    }
};
struct EpiResid {
    float* out; const float* resid;
    DI void operator()(const f32x16 (&acc)[4][2], int nb, int tb, int l32, int h) const {
#pragma unroll
        for (int ti = 0; ti < 2; ++ti) {
            const int t = tb + ti * 32 + l32;
#pragma unroll
            for (int ni = 0; ni < 4; ++ni)
#pragma unroll
                for (int g = 0; g < 4; ++g) {
                    const int n = nb + ni * 32 + 8 * g + 4 * h;
                    f32x4 r = *(const f32x4*)(resid + (size_t)t * 1024 + n);
                    r[0] += acc[ni][ti][4 * g]; r[1] += acc[ni][ti][4 * g + 1]; r[2] += acc[ni][ti][4 * g + 2]; r[3] += acc[ni][ti][4 * g + 3];
                    *(f32x4*)(out + (size_t)t * 1024 + n) = r;
                    if (g == 3) __builtin_amdgcn_sched_barrier(0);
                }
        }
    }
};

namespace pg8 {
#define PG8_LAS __attribute__((address_space(3)))
typedef unsigned short bf16_t;
typedef short bf16x8 __attribute__((ext_vector_type(8)));
typedef float f32x4 __attribute__((ext_vector_type(4)));
typedef unsigned u32x4 __attribute__((ext_vector_type(4)));
constexpr int BM = 256, BK = 64, HALF = 128, HTB = HALF * BK * 2  , STAGE_BYTES = 8 * HTB, NXCD = 8, WGM = 4;

__host__ __device__ __forceinline__ int lds_byte(int r, int c) { const int st = (r >> 4) * 2 + (c >> 5), rr = r & 15, cc = c & 31, ob = rr * 64 + cc * 2; return st * 1024 + (ob ^ (((ob >> 9) & 1) << 5)); }
__host__ __device__ __forceinline__ void stage_rc(int b, int& R, int& C) { const int st = b / 1024, sb = b % 1024, swz = sb ^ (((sb >> 9) & 1) << 5); R = (st >> 1) * 16 + swz / 64; C = (st & 1) * 32 + (swz % 64) / 2; }
__host__ __device__ __forceinline__ int perm32(int rho) { const int n = rho >> 4, i = rho & 15; return 8 * (i >> 2) + 4 * n + (i & 3); }

struct Unit { int pm, pn; };
struct Gemm { const bf16_t* A; const bf16_t* Bt; int M, N, K; };

struct StaticOrder {
    int nM, nN, nwg, G, c;
    __host__ __device__ void init(int M, int N, int G_, int c_) { nM = M / BM; nN = N / BM; nwg = nM * nN; G = G_; c = c_; }
    __host__ __device__ bool next(int i, Unit& u) const {
        const long L = (long)i * G + c; if (L >= nwg) return false;
        int wgid = (int)L; { const int q = nwg / NXCD, r = nwg % NXCD, xcd = wgid % NXCD, off = wgid / NXCD; wgid = (xcd < r ? xcd * (q + 1) : r * (q + 1) + (xcd - r) * q) + off; }
        const int nig = WGM * nN, gid = wgid / nig, fm = gid * WGM, gsz = (nM - fm) < WGM ? (nM - fm) : WGM;
        u.pm = fm + ((wgid % nig) % gsz); u.pn = (wgid % nig) / gsz; return true;
    }
    __device__ __forceinline__ void a_ready(const Unit&) const {}
    __device__ __forceinline__ void done(const Unit&) const {}
};
template <class Epi, class Sched, bool ALIGN_EPI = false, bool SP2 = false>
__device__ __forceinline__ void gemm_phase(PG8_LAS unsigned char* lds, const Gemm g, const Sched& S, const Epi& E) {
    const int tid = tid_fresh(), wid = __builtin_amdgcn_readfirstlane(tid >> 6), lane = tid & 63, wr = wid >> 2, wc = wid & 3, fr = lane & 15, fq = lane >> 4;
    const int K = g.K, nt = K / BK;
    unsigned voffA[2], voffB[2];
#pragma unroll
    for (int i = 0; i < 2; ++i) { int R, C; stage_rc(tid * 16 + i * 8192, R, C); const int Rb = Epi::PERM ? ((R & ~31) + perm32(R & 31)) : R;
        voffA[i] = (unsigned)(R * K + C) * 2u; voffB[i] = (unsigned)(Rb * K + C) * 2u; }
    const size_t kstep = (size_t)(BK * 2);
    const size_t hstep = (size_t)HALF * K * 2;
    const size_t tstep = 2 * hstep;
    const unsigned ldsw = (unsigned)wid * 1024u;
    const int aoff = lds_byte(wr * 64 + fr, fq * 8), boff = lds_byte(wc * 32 + fr, fq * 8);
#define PG8_SA(b, h) (((b) * 2 + (h)) * HTB)
#define PG8_SB(b, h) ((4 + (b) * 2 + (h)) * HTB)
#define PG8_STAGE(bufoff, gbase, voff) do { _Pragma("unroll") for (int _i = 0; _i < 2; ++_i) \
        __builtin_amdgcn_global_load_lds((const unsigned*)((const char*)(gbase) + (voff)[_i]), (PG8_LAS unsigned*)(lds + (bufoff) + ldsw + _i * 8192), 16, 0, 0); } while (0)
#define PG8_LDA(dst, b, h) do { _Pragma("unroll") for (int m = 0; m < 4; ++m) _Pragma("unroll") for (int k = 0; k < 2; ++k) dst[m][k] = *(const PG8_LAS bf16x8*)(lds + PG8_SA(b, h) + aoff + m * 2048 + k * 1024); } while (0)
#define PG8_LDB(dst, b, h) do { _Pragma("unroll") for (int n = 0; n < 2; ++n) _Pragma("unroll") for (int k = 0; k < 2; ++k) dst[n][k] = *(const PG8_LAS bf16x8*)(lds + PG8_SB(b, h) + boff + n * 2048 + k * 1024); } while (0)
#define PG8_MMA(ai, bj, At, Bt) do { __builtin_amdgcn_s_setprio(1); _Pragma("unroll") for (int m = 0; m < 4; ++m) _Pragma("unroll") for (int n = 0; n < 2; ++n) _Pragma("unroll") for (int k = 0; k < 2; ++k) \
        acc[ai][bj][m][n] = __builtin_amdgcn_mfma_f32_16x16x32_bf16(Bt[n][k], At[m][k], acc[ai][bj][m][n], 0, 0, 0); __builtin_amdgcn_s_setprio(0); } while (0)
#define PG8_WAIT_V(n) asm volatile("s_waitcnt vmcnt(" #n ")" ::: "memory")
#define PG8_WAIT_L(n) asm volatile("s_waitcnt lgkmcnt(" #n ")" ::: "memory")
#define PG8_BAR __builtin_amdgcn_s_barrier()
#define PG8_SCHED __builtin_amdgcn_sched_barrier(0)
    Unit cur, nxt; int ui = 0;
    if (!S.next(0, cur)) return;
    f32x4 acc[2][2][4][2];
#pragma unroll
    for (int a = 0; a < 2; ++a)
#pragma unroll
        for (int b = 0; b < 2; ++b)
#pragma unroll
            for (int m = 0; m < 4; ++m)
#pragma unroll
                for (int n = 0; n < 2; ++n) acc[a][b][m][n] = (f32x4){0.f, 0.f, 0.f, 0.f};
    bf16x8 At[4][2], B0[2][2], B1[2][2];
    const char* cA = (const char*)g.A + (size_t)cur.pm * tstep; const char* cB = (const char*)g.Bt + (size_t)cur.pn * tstep;
    S.a_ready(cur);
    if constexpr (SP2) {
        PG8_STAGE(PG8_SB(0, 0), cB, voffB); PG8_STAGE(PG8_SB(0, 1), cB + hstep, voffB); PG8_STAGE(PG8_SA(0, 0), cA, voffA); PG8_STAGE(PG8_SA(0, 1), cA + hstep, voffA);
        if (wr == 1) PG8_BAR;
        PG8_WAIT_V(2); PG8_BAR;
        PG8_STAGE(PG8_SB(1, 0), cB + kstep, voffB); PG8_STAGE(PG8_SA(1, 0), cA + kstep, voffA); PG8_STAGE(PG8_SB(1, 1), cB + hstep + kstep, voffB);
        PG8_WAIT_V(6); PG8_BAR;
    } else {
        PG8_STAGE(PG8_SB(0, 0), cB, voffB); PG8_STAGE(PG8_SA(0, 0), cA, voffA); PG8_STAGE(PG8_SB(0, 1), cB + hstep, voffB); PG8_STAGE(PG8_SA(0, 1), cA + hstep, voffA);
        if (wr == 1) PG8_BAR;
        PG8_WAIT_V(4); PG8_BAR;
        PG8_STAGE(PG8_SB(1, 0), cB + kstep, voffB); PG8_STAGE(PG8_SA(1, 0), cA + kstep, voffA); PG8_STAGE(PG8_SB(1, 1), cB + hstep + kstep, voffB);
        PG8_WAIT_V(6); PG8_BAR;
    }
    for (;;) {
        const bool has_next = S.next(ui + 1, nxt);
        const char* nA = has_next ? (const char*)g.A + (size_t)nxt.pm * tstep : cA; const char* nB = has_next ? (const char*)g.Bt + (size_t)nxt.pn * tstep : cB;
        for (int t = 0; t < nt; t += 2) {
            const bool last = (t == nt - 2);
            const char* a1 = cA + (size_t)(t + 1) * kstep;
            const char* a2 = last ? nA : cA + (size_t)(t + 2) * kstep; const char* b2 = last ? nB : cB + (size_t)(t + 2) * kstep;
            const char* a3 = a2 + kstep; const char* b3 = b2 + kstep;
            if (last && has_next) S.a_ready(nxt);
            if constexpr (SP2) {
            PG8_LDB(B0, 0, 0); PG8_LDB(B1, 0, 1); PG8_SCHED; PG8_LDA(At, 0, 0); PG8_STAGE(PG8_SA(1, 1), a1 + hstep, voffA);
            PG8_WAIT_V(8); PG8_WAIT_L(0); PG8_BAR; PG8_MMA(0, 0, At, B0); PG8_MMA(0, 1, At, B1); PG8_BAR; PG8_SCHED;
            PG8_LDA(At, 0, 1); PG8_STAGE(PG8_SB(0, 0), b2, voffB); PG8_STAGE(PG8_SB(0, 1), b2 + hstep, voffB); PG8_STAGE(PG8_SA(0, 0), a2, voffA);
            PG8_WAIT_V(8); PG8_WAIT_L(0); PG8_BAR; PG8_MMA(1, 0, At, B0); PG8_MMA(1, 1, At, B1); PG8_BAR; PG8_SCHED;
            PG8_LDB(B0, 1, 0); PG8_LDB(B1, 1, 1); PG8_SCHED; PG8_LDA(At, 1, 0); PG8_STAGE(PG8_SA(0, 1), a2 + hstep, voffA);
            PG8_WAIT_V(8); PG8_WAIT_L(0); PG8_BAR; PG8_MMA(0, 0, At, B0); PG8_MMA(0, 1, At, B1); PG8_BAR; PG8_SCHED;
            PG8_LDA(At, 1, 1); PG8_STAGE(PG8_SB(1, 0), b3, voffB); PG8_STAGE(PG8_SB(1, 1), b3 + hstep, voffB); PG8_STAGE(PG8_SA(1, 0), a3, voffA);
            PG8_WAIT_V(8); PG8_WAIT_L(0); PG8_BAR; PG8_MMA(1, 0, At, B0); PG8_MMA(1, 1, At, B1); PG8_BAR; PG8_SCHED;
            } else {
            PG8_LDB(B0, 0, 0); PG8_SCHED; PG8_LDA(At, 0, 0); PG8_STAGE(PG8_SA(1, 1), a1 + hstep, voffA);
            PG8_WAIT_L(8); PG8_BAR; PG8_WAIT_L(0); PG8_MMA(0, 0, At, B0); PG8_BAR; PG8_SCHED;
            PG8_LDB(B1, 0, 1); PG8_STAGE(PG8_SB(0, 0), b2, voffB);
            PG8_BAR; PG8_WAIT_L(0); PG8_MMA(0, 1, At, B1); PG8_BAR;
            PG8_LDA(At, 0, 1); PG8_STAGE(PG8_SA(0, 0), a2, voffA);
            PG8_BAR; PG8_WAIT_L(0); PG8_MMA(1, 0, At, B0); PG8_BAR; PG8_SCHED;
            PG8_STAGE(PG8_SB(0, 1), b2 + hstep, voffB);
            PG8_WAIT_V(6); PG8_BAR; PG8_MMA(1, 1, At, B1); PG8_BAR;
            PG8_LDB(B0, 1, 0); PG8_SCHED; PG8_LDA(At, 1, 0); PG8_STAGE(PG8_SA(0, 1), a2 + hstep, voffA);
            PG8_WAIT_L(8); PG8_BAR; PG8_WAIT_L(0); PG8_MMA(0, 0, At, B0); PG8_BAR; PG8_SCHED;
            PG8_LDB(B1, 1, 1); PG8_STAGE(PG8_SB(1, 0), b3, voffB);
            PG8_BAR; PG8_WAIT_L(0); PG8_MMA(0, 1, At, B1); PG8_BAR;
            PG8_LDA(At, 1, 1); PG8_STAGE(PG8_SA(1, 0), a3, voffA);
            PG8_BAR; PG8_WAIT_L(0); PG8_MMA(1, 0, At, B0); PG8_BAR; PG8_SCHED;
            PG8_STAGE(PG8_SB(1, 1), b3 + hstep, voffB);
            PG8_WAIT_V(6); PG8_BAR; PG8_MMA(1, 1, At, B1); PG8_BAR;
            }
        }
        if constexpr (ALIGN_EPI) { if (wr == 0) PG8_BAR; }
        if constexpr (!Epi::AFTER_DRAIN) { E(acc, cur, wr, wc, fr, fq); S.done(cur); }
        if (!has_next) break;
#pragma unroll
        for (int a = 0; a < 2; ++a)
#pragma unroll
            for (int b = 0; b < 2; ++b)
#pragma unroll
                for (int m = 0; m < 4; ++m)
#pragma unroll
                    for (int n = 0; n < 2; ++n) acc[a][b][m][n] = (f32x4){0.f, 0.f, 0.f, 0.f};
        cur = nxt; cA = nA; cB = nB; ++ui;
        if constexpr (ALIGN_EPI) { if (wr == 1) PG8_BAR; }
    }
    PG8_WAIT_V(0);
    if constexpr (!ALIGN_EPI) { if (wr == 0) PG8_BAR; }
    PG8_BAR;
    if constexpr (Epi::AFTER_DRAIN) { E.fused(acc, cur, wr, wc, fr, fq, lds, wid, lane); S.done(cur); }
#undef PG8_SA
#undef PG8_SB
#undef PG8_STAGE
#undef PG8_LDA
#undef PG8_LDB
#undef PG8_MMA
#undef PG8_WAIT_V
#undef PG8_WAIT_L
#undef PG8_BAR
#undef PG8_SCHED
}
}

struct EpiInproj {
    static constexpr bool PERM = true, AFTER_DRAIN = false;
    bf16_t* O; const float* rs; bf16_t* CQ; bf16_t* CKV; float* ssq_q; float* ssq_kv; bf16_t* KR; const float* cosm; const float* sinm;
    DI void operator()(const pg8::f32x4 (&acc)[2][2][4][2], const pg8::Unit& u, int wr, int wc, int fr, int fq) const {
        const int row0 = u.pm * 256 + wr * 64 + fr, col0 = u.pn * 256 + wc * 32 + 8 * fq;
        const bool lat = u.pn < 3;
#pragma unroll
        for (int ai = 0; ai < 2; ++ai)
#pragma unroll
            for (int m = 0; m < 4; ++m) {
                const int row = row0 + ai * 128 + m * 16; const float r = __builtin_amdgcn_rsqf(rs[row] * (1.0f / 1024.0f) + EPSN);
                float sq = 0.f, skv = 0.f;
#pragma unroll
                for (int bj = 0; bj < 2; ++bj) {
                    const int c = col0 + bj * 128;
                    if (c < INW) {
                        const pg8::f32x4 v0 = acc[ai][bj][m][0] * r, v1 = acc[ai][bj][m][1] * r;
                        u32x4 w; w[0] = pk_bf16(v0[0], v0[1]); w[1] = pk_bf16(v0[2], v0[3]); w[2] = pk_bf16(v1[0], v1[1]); w[3] = pk_bf16(v1[2], v1[3]);
                        bf16_t* dst = (c < C_CKV) ? (CQ + (unsigned)(row * 384 + c)) : (c < C_KR) ? (CKV + (unsigned)(row * 256 + (c - C_CKV))) : (O + (unsigned)(row * INW + c));
                        *(u32x4*)dst = w;
                        if (lat && c < C_KR) {
                            float s = 0.f;
#pragma unroll
                            for (int e = 0; e < 4; ++e) { const float a = bf_lo(w[e]), b = bf_hi(w[e]); s += a * a + b * b; }
                            if (c < C_CKV) sq += s; else skv += s;
                        }
                        if (lat && u.pn == 2 && bj == 1 && wc == 0) {
                            float own[8], par[8];
#pragma unroll
                            for (int e = 0; e < 4; ++e) { own[2 * e] = bf_lo(w[e]); own[2 * e + 1] = bf_hi(w[e]); }
#pragma unroll
                            for (int e = 0; e < 8; ++e) par[e] = __shfl_xor(own[e], 32);
                            const int spos = row & 8191, i0 = 8 * (fq & 1);
                            const f32x4 c0 = *(const f32x4*)(cosm + spos * 16 + i0), c1 = *(const f32x4*)(cosm + spos * 16 + i0 + 4);
                            const f32x4 s0 = *(const f32x4*)(sinm + spos * 16 + i0), s1 = *(const f32x4*)(sinm + spos * 16 + i0 + 4);
                            const float cc[8] = {c0[0], c0[1], c0[2], c0[3], c1[0], c1[1], c1[2], c1[3]};
                            const float sn[8] = {s0[0], s0[1], s0[2], s0[3], s1[0], s1[1], s1[2], s1[3]};
                            float y[8];
#pragma unroll
                            for (int e = 0; e < 8; ++e) y[e] = (fq < 2) ? (own[e] * cc[e] - par[e] * sn[e]) : (par[e] * sn[e] + own[e] * cc[e]);
                            u32x4 kw; kw[0] = pk_bf16(y[0], y[1]); kw[1] = pk_bf16(y[2], y[3]); kw[2] = pk_bf16(y[4], y[5]); kw[3] = pk_bf16(y[6], y[7]);
                            *(u32x4*)(KR + (unsigned)(row * 32 + 8 * fq)) = kw;
                        }
                    }
                }
                if (lat) {
                    sq += __shfl_xor(sq, 16); sq += __shfl_xor(sq, 32);
                    skv += __shfl_xor(skv, 16); skv += __shfl_xor(skv, 32);
                    if (fq == 0) {
                        if (u.pn < 2) (void)__hip_atomic_fetch_add(ssq_q + row, sq, __ATOMIC_RELAXED, __HIP_MEMORY_SCOPE_AGENT);
                        if (u.pn > 0) (void)__hip_atomic_fetch_add(ssq_kv + row, skv, __ATOMIC_RELAXED, __HIP_MEMORY_SCOPE_AGENT);
                    }
                }
            }
    }
};
struct EpiOutRes {
    static constexpr bool PERM = false, AFTER_DRAIN = false;
    float* out; const float* resid; bf16_t* xb; float* ssq;
    DI void operator()(const pg8::f32x4 (&acc)[2][2][4][2], const pg8::Unit& u, int wr, int wc, int fr, int fq) const {
        const int row0 = u.pm * 256 + wr * 64 + fr, col0 = u.pn * 256 + wc * 32 + 4 * fq;
        float ssum[2][4];
        f32x4 rb[2][2][2][2];
#define EPI_LOAD(BUF, AI, M0) do { _Pragma("unroll") for (int mm = 0; mm < 2; ++mm) _Pragma("unroll") for (int bj = 0; bj < 2; ++bj) _Pragma("unroll") for (int n = 0; n < 2; ++n) \
            rb[BUF][mm][bj][n] = *(const f32x4*)(resid + (size_t)(row0 + (AI) * 128 + ((M0) + mm) * 16) * 1024 + col0 + bj * 128 + n * 16); } while (0)
#define EPI_USE(BUF, AI, M0) do { _Pragma("unroll") for (int mm = 0; mm < 2; ++mm) { const size_t ro = (size_t)(row0 + (AI) * 128 + ((M0) + mm) * 16) * 1024 + col0; float s = 0.f; \
            _Pragma("unroll") for (int bj = 0; bj < 2; ++bj) _Pragma("unroll") for (int n = 0; n < 2; ++n) { \
                const f32x4 r = rb[BUF][mm][bj][n] + acc[AI][bj][(M0) + mm][n]; \
                *(f32x4*)(out + ro + bj * 128 + n * 16) = r; \
                if (ssq) { u32x2 w; w[0] = pk_bf16(r[0], r[1]); w[1] = pk_bf16(r[2], r[3]); *(u32x2*)(xb + ro + bj * 128 + n * 16) = w; \
                           s += r[0] * r[0] + r[1] * r[1] + r[2] * r[2] + r[3] * r[3]; } } \
            ssum[AI][(M0) + mm] = s; } } while (0)
        EPI_LOAD(0, 0, 0); SB();
        EPI_LOAD(1, 0, 2); SB();
        EPI_USE(0, 0, 0); SB();
        EPI_LOAD(0, 1, 0); SB();
        EPI_USE(1, 0, 2); SB();
        EPI_LOAD(1, 1, 2); SB();
        EPI_USE(0, 1, 0); SB();
        EPI_USE(1, 1, 2); SB();
#undef EPI_LOAD
#undef EPI_USE
        if (ssq) {
#pragma unroll
            for (int ai = 0; ai < 2; ++ai)
#pragma unroll
                for (int m = 0; m < 4; ++m) {
                    float s = ssum[ai][m];
                    s += __shfl_xor(s, 16); s += __shfl_xor(s, 32);
                    if (fq == 0) (void)__hip_atomic_fetch_add(ssq + row0 + ai * 128 + m * 16, s, __ATOMIC_RELAXED, __HIP_MEMORY_SCOPE_AGENT);
                }
        }
    }
};

struct EpiUpRow {
    static constexpr bool PERM = true, AFTER_DRAIN = false;
    bf16_t* O; const float* ss; int ld; float invk;
    DI void operator()(const pg8::f32x4 (&acc)[2][2][4][2], const pg8::Unit& u, int wr, int wc, int fr, int fq) const {
        const int row0 = u.pm * 256 + wr * 64 + fr, col0 = u.pn * 256 + wc * 32 + 8 * fq;
#pragma unroll
        for (int ai = 0; ai < 2; ++ai)
#pragma unroll
            for (int m = 0; m < 4; ++m) {
                const int row = row0 + ai * 128 + m * 16; const float r = __builtin_amdgcn_rsqf(ss[row] * invk + EPSN);
#pragma unroll
                for (int bj = 0; bj < 2; ++bj) {
                    const pg8::f32x4 v0 = acc[ai][bj][m][0] * r, v1 = acc[ai][bj][m][1] * r;
                    u32x4 w; w[0] = pk_bf16(v0[0], v0[1]); w[1] = pk_bf16(v0[2], v0[3]); w[2] = pk_bf16(v1[0], v1[1]); w[3] = pk_bf16(v1[2], v1[3]);
                    *(u32x4*)(O + (unsigned)(row * ld + col0 + bj * 128)) = w;
                }
                SB();
            }
    }
};
DI void latent_phase(const Params& p) {
    unsigned char* ws = p.ws;
    bf16_t* P = (bf16_t*)(ws + WS_P); bf16_t* KR = (bf16_t*)(ws + WS_KR);
    float* rstdq = (float*)(ws + WS_RSTDQ); float* rstdkv = (float*)(ws + WS_RSTDKV);
    const bf16_t* CQb = (const bf16_t*)(ws + WS_CQ); const bf16_t* CKVb = (const bf16_t*)(ws + WS_CKV);
    const float* cosm = (const float*)(ws + WS_COSM); const float* sinm = (const float*)(ws + WS_SINM);
    const float* cosd = (const float*)(ws + WS_COSD); const float* sind = (const float*)(ws + WS_SIND);
    const int tid = tid_fresh(), wave = tid >> 6, lane = tid & 63;
    for (int t = bid_fresh() * 8 + wave; t < T; t += gridDim.x * 8) {
        bf16_t* prow = P + (size_t)t * INW; const int s = t & 8191, b = t >> 13;
        float sq = 0.f, skv = 0.f;
#pragma unroll
        for (int i = 0; i < 3; ++i) { const unsigned u = ((const unsigned*)(CQb + (size_t)t * 384))[lane + 64 * i]; const float a = bf_lo(u), c = bf_hi(u); sq += a * a + c * c; }
#pragma unroll
        for (int i = 0; i < 2; ++i) { const unsigned u = ((const unsigned*)(CKVb + (size_t)t * 256))[lane + 64 * i]; const float a = bf_lo(u), c = bf_hi(u); skv += a * a + c * c; }
        sq = wave_sum(sq); skv = wave_sum(skv);
        if (lane == 0) { rstdq[t] = __builtin_amdgcn_rsqf(sq * (1.0f / 384.0f) + EPSN); rstdkv[t] = __builtin_amdgcn_rsqf(skv * (1.0f / 256.0f) + EPSN); }
        {
            const int hd = lane >> 3, vb = (lane & 7) * 4, i0 = vb & 15; const bool second = vb >= 16;
            const u32x2 a1 = *(const u32x2*)(prow + C_KR + i0), a2 = *(const u32x2*)(prow + C_KR + 16 + i0);
            const f32x4 c = *(const f32x4*)(cosm + s * 16 + i0), sn = *(const f32x4*)(sinm + s * 16 + i0);
            const float x1[4] = {bf_lo(a1[0]), bf_hi(a1[0]), bf_lo(a1[1]), bf_hi(a1[1])};
            const float x2[4] = {bf_lo(a2[0]), bf_hi(a2[0]), bf_lo(a2[1]), bf_hi(a2[1])};
            float y[4];
#pragma unroll
            for (int e = 0; e < 4; ++e) y[e] = second ? (x1[e] * sn[e] + x2[e] * c[e]) : (x1[e] * c[e] - x2[e] * sn[e]);
            u32x2 o; o[0] = pk_bf16(y[0], y[1]); o[1] = pk_bf16(y[2], y[3]);
            if (hd == 0) *(u32x2*)(KR + (size_t)t * 32 + vb) = o;
        }
    }
}

DI void dil_item(const Params& p, int it, ldsp lds) {
    unsigned char* ws = p.ws;
    bf16_t* P = (bf16_t*)(ws + WS_P); float* LSE = (float*)(ws + WS_LSE);
    const float* cosd = (const float*)(ws + WS_COSD); const float* sind = (const float*)(ws + WS_SIND);
    const int tid = tid_fresh(), wave = tid >> 6, lane = tid & 63, l32 = lane & 31, h = lane >> 5;
    const int g = it >> 9, rem = it & 511, b = rem >> 8, head = (rem >> 5) & 7, blk = rem & 31;
    const int dsh = 2 * g, L = 8192 >> dsh;
    const int j = blk >> (5 - dsh), rb = blk & ((32 >> dsh) - 1), r0 = rb * 256;
    bf16_t* Pb = P + (size_t)(b * 8192) * INW + C_DQ + g * 1536 + head * 64;
    {
        u32x4 kreg[6], vreg[6];
#pragma unroll
        for (int i = 0; i < 6; ++i) {
            const int c = tid + 512 * i, row = c >> 3, ch = c & 7, r = r0 - 64 + row;
            const bool valid = (r >= 0) && (r < L);
            const int s = j + ((valid ? r : 0) << dsh);
            const bf16_t* src = Pb + (size_t)s * INW + ch * 8;
            u32x4 z = {0u, 0u, 0u, 0u};
            kreg[i] = valid ? *(const u32x4*)(src + 512) : z;
            vreg[i] = valid ? *(const u32x4*)(src + 1024) : z;
            u32x4 pw;
#pragma unroll
            for (int e = 0; e < 4; ++e) pw[e] = __shfl_xor(kreg[i][e], 1);
            if (ch < 2) {
                const f32x4 c0 = *(const f32x4*)(cosd + s * 8), c1 = *(const f32x4*)(cosd + s * 8 + 4);
                const f32x4 s0 = *(const f32x4*)(sind + s * 8), s1 = *(const f32x4*)(sind + s * 8 + 4);
                const float cc[8] = {c0[0], c0[1], c0[2], c0[3], c1[0], c1[1], c1[2], c1[3]};
                const float ss[8] = {s0[0], s0[1], s0[2], s0[3], s1[0], s1[1], s1[2], s1[3]};
                const u32x4 own = kreg[i];
                u32x4 res;
#pragma unroll
                for (int e = 0; e < 4; ++e) {
                    const float x1l = ch == 0 ? bf_lo(own[e]) : bf_lo(pw[e]), x1h = ch == 0 ? bf_hi(own[e]) : bf_hi(pw[e]);
                    const float x2l = ch == 0 ? bf_lo(pw[e]) : bf_lo(own[e]), x2h = ch == 0 ? bf_hi(pw[e]) : bf_hi(own[e]);
                    const float yl = ch == 0 ? (x1l * cc[2 * e] - x2l * ss[2 * e]) : (x1l * ss[2 * e] + x2l * cc[2 * e]);
                    const float yh = ch == 0 ? (x1h * cc[2 * e + 1] - x2h * ss[2 * e + 1]) : (x1h * ss[2 * e + 1] + x2h * cc[2 * e + 1]);
                    res[e] = pk_bf16(yl, yh);
                }
                kreg[i] = res;
            }
        }
#pragma unroll
        for (int i = 0; i < 6; ++i) {
            const int c = tid + 512 * i, row = c >> 3, ch = c & 7;
            *(LAS u32x4*)(lds + row * 144 + ch * 16) = kreg[i];
            *(LAS u32x4*)(lds + 55296 + row * 128 + ((ch ^ (((row >> 1) & 1) << 2)) << 4)) = vreg[i];
        }
    }
    __syncthreads();
    const int rq = r0 + wave * 32 + l32, sq = j + (rq << dsh);
    bf16_t* qrow = Pb + (size_t)sq * INW;
    bf16x8 qf[4];
#pragma unroll
    for (int ks = 0; ks < 4; ++ks) qf[ks] = *(const bf16x8*)(qrow + ks * 16 + h * 8);
    {
        const u32x4 own = __builtin_bit_cast(u32x4, qf[0]);
        u32x4 pw, res;
#pragma unroll
        for (int e = 0; e < 4; ++e) pw[e] = __shfl_xor(own[e], 32);
        const f32x4 c0 = *(const f32x4*)(cosd + sq * 8), c1 = *(const f32x4*)(cosd + sq * 8 + 4);
        const f32x4 s0 = *(const f32x4*)(sind + sq * 8), s1 = *(const f32x4*)(sind + sq * 8 + 4);
        const float cc[8] = {c0[0], c0[1], c0[2], c0[3], c1[0], c1[1], c1[2], c1[3]};
        const float ss[8] = {s0[0], s0[1], s0[2], s0[3], s1[0], s1[1], s1[2], s1[3]};
#pragma unroll
        for (int e = 0; e < 4; ++e) {
            const float x1l = h == 0 ? bf_lo(own[e]) : bf_lo(pw[e]), x1h = h == 0 ? bf_hi(own[e]) : bf_hi(pw[e]);
            const float x2l = h == 0 ? bf_lo(pw[e]) : bf_lo(own[e]), x2h = h == 0 ? bf_hi(pw[e]) : bf_hi(own[e]);
            const float yl = h == 0 ? (x1l * cc[2 * e] - x2l * ss[2 * e]) : (x1l * ss[2 * e] + x2l * cc[2 * e]);
            const float yh = h == 0 ? (x1h * cc[2 * e + 1] - x2h * ss[2 * e + 1]) : (x1h * ss[2 * e + 1] + x2h * cc[2 * e + 1]);
            res[e] = pk_bf16(yl, yh);
        }
        qf[0] = __builtin_bit_cast(bf16x8, res);
    }
    f32x16 sc[5];
    {
        bf16x8 kf[2][4];
        const int kbase = (wave * 32 + l32) * 144 + h * 16;
#pragma unroll
        for (int ks = 0; ks < 4; ++ks) kf[0][ks] = *(LAS bf16x8*)(lds + kbase + ks * 32);
#pragma unroll
        for (int kt = 0; kt < 5; ++kt) {
            if (kt < 4) {
#pragma unroll
                for (int ks = 0; ks < 4; ++ks) kf[(kt + 1) & 1][ks] = *(LAS bf16x8*)(lds + kbase + (kt + 1) * 32 * 144 + ks * 32);
            }
            SB();
#pragma unroll
            for (int i = 0; i < 16; ++i) sc[kt][i] = 0.f;
#pragma unroll
            for (int ks = 0; ks < 4; ++ks) sc[kt] = MFMA(kf[kt & 1][ks], qf[ks], sc[kt]);
            SB();
        }
    }
    const float cs = 0.125f * LOG2E;
    float mx = -1e30f;
    const int w0 = r0 + wave * 32;
    if (w0 - 64 >= 0 && w0 + 96 <= L) {
#pragma unroll
        for (int kt = 0; kt < 5; ++kt)
#pragma unroll
            for (int i = 0; i < 16; ++i) {
                const int cr = (i & 3) + 8 * (i >> 2) + 4 * h;
                const bool valid = (kt == 0) ? (cr >= l32) : (kt == 4) ? (cr <= l32) : true;
                const float v = valid ? sc[kt][i] * cs : -1e30f;
                sc[kt][i] = v; mx = fmaxf(mx, v);
            }
    } else {
#pragma unroll
        for (int kt = 0; kt < 5; ++kt)
#pragma unroll
            for (int i = 0; i < 16; ++i) {
                const int diff = -64 + 32 * kt + ((i & 3) + 8 * (i >> 2) + 4 * h) - l32;
                const int rk = rq + diff;
                const bool valid = (diff >= -64) && (diff <= 64) && (rk >= 0) && (rk < L);
                const float v = valid ? sc[kt][i] * cs : -1e30f;
                sc[kt][i] = v; mx = fmaxf(mx, v);
            }
    }
    mx = fmaxf(mx, __shfl_xor(mx, 32));
    float lsum = 0.f;
#pragma unroll
    for (int kt = 0; kt < 5; ++kt)
#pragma unroll
        for (int i = 0; i < 16; ++i) { const float e = __builtin_amdgcn_exp2f(sc[kt][i] - mx); sc[kt][i] = e; lsum += e; }
    lsum += __shfl_xor(lsum, 32);
    f32x16 o[2];
#pragma unroll
    for (int d = 0; d < 2; ++d)
#pragma unroll
        for (int i = 0; i < 16; ++i) o[d][i] = 0.f;
    const int q4 = (lane & 15) >> 2, p4 = lane & 3, blkk = (lane >> 4) & 1, xq = (q4 >> 1) & 1;
    int voff[2];
#pragma unroll
    for (int d = 0; d < 2; ++d) voff[d] = 55296 + (wave * 32 + 4 * h + q4) * 128 + ((4 * (d ^ xq) + 2 * blkk + (p4 >> 1)) << 4) + (p4 & 1) * 8;
    {
        s16x4 vlo[2][2][2], vhi[2][2][2];
#pragma unroll
        for (int s2 = 0; s2 < 2; ++s2)
#pragma unroll
            for (int d = 0; d < 2; ++d) {
                vlo[0][s2][d] = __builtin_amdgcn_ds_read_tr16_b64_v4i16((LAS s16x4*)(lds + voff[d] + (s2 * 16) * 128));
                vhi[0][s2][d] = __builtin_amdgcn_ds_read_tr16_b64_v4i16((LAS s16x4*)(lds + voff[d] + (s2 * 16 + 8) * 128));
            }
#pragma unroll
        for (int kt = 0; kt < 5; ++kt) {
            if (kt < 4) {
#pragma unroll
                for (int s2 = 0; s2 < 2; ++s2)
#pragma unroll
                    for (int d = 0; d < 2; ++d) {
                        vlo[(kt + 1) & 1][s2][d] = __builtin_amdgcn_ds_read_tr16_b64_v4i16((LAS s16x4*)(lds + voff[d] + ((kt + 1) * 32 + s2 * 16) * 128));
                        vhi[(kt + 1) & 1][s2][d] = __builtin_amdgcn_ds_read_tr16_b64_v4i16((LAS s16x4*)(lds + voff[d] + ((kt + 1) * 32 + s2 * 16 + 8) * 128));
                    }
            }
            SB();
#pragma unroll
            for (int s2 = 0; s2 < 2; ++s2) {
                u32x4 pw;
#pragma unroll
                for (int e = 0; e < 4; ++e) pw[e] = pk_bf16(sc[kt][8 * s2 + 2 * e], sc[kt][8 * s2 + 2 * e + 1]);
                const bf16x8 pf = __builtin_bit_cast(bf16x8, pw);
#pragma unroll
                for (int d = 0; d < 2; ++d) {
                    const bf16x8 vf = __builtin_shufflevector(vlo[kt & 1][s2][d], vhi[kt & 1][s2][d], 0, 1, 2, 3, 4, 5, 6, 7);
                    o[d] = MFMA(vf, pf, o[d]);
                }
            }
            SB();
        }
    }
    const float inv = __builtin_amdgcn_rcpf(lsum);
#pragma unroll
    for (int d = 0; d < 2; ++d)
#pragma unroll
        for (int gq = 0; gq < 4; ++gq) {
            u32x2 ov; ov[0] = pk_bf16(o[d][4 * gq] * inv, o[d][4 * gq + 1] * inv); ov[1] = pk_bf16(o[d][4 * gq + 2] * inv, o[d][4 * gq + 3] * inv);
            *(u32x2*)(qrow + d * 32 + 8 * gq + 4 * h) = ov;
        }
    if (h == 0) LSE[((size_t)g * T + (b * 8192 + sq)) * 8 + head] = mx + __builtin_amdgcn_logf(lsum);
    __syncthreads();
}

DI void mla_item(const Params& p, int b, int head, int qb, ldsp lds) {
    unsigned char* ws = p.ws;
    const bf16_t* P = (const bf16_t*)(ws + WS_P); const bf16_t* Q = (const bf16_t*)(ws + WS_Q);
    const bf16_t* KVb = (const bf16_t*)(ws + WS_KF) + (size_t)(b * 8192) * 1024 + head * 128;
    const bf16_t* KRb = (const bf16_t*)(ws + WS_KR) + (size_t)(b * 8192) * 32;
    bf16_t* MIX = (bf16_t*)(ws + WS_XB);
    const float* cosm = (const float*)(ws + WS_COSM); const float* sinm = (const float*)(ws + WS_SINM);
    const float* LSE = (const float*)(ws + WS_LSE);
    const int tid = tid_fresh(), wave = tid >> 6, lane = tid & 63, l32 = lane & 31, h = lane >> 5;
    const int sq = qb * 256 + wave * 32 + l32, tq = b * 8192 + sq;
    bf16x8 qf[6];
    {
        const float qs = 0.10206207261596575f * LOG2E;
        const bf16_t* qrow = Q + (size_t)tq * 768 + head * 96 + h * 8;
#pragma unroll
        for (int ks = 0; ks < 4; ++ks) {
            const u32x4 raw = *(const u32x4*)(qrow + ks * 16);
            u32x4 o;
#pragma unroll
            for (int e = 0; e < 4; ++e) o[e] = pk_bf16(bf_lo(raw[e]) * qs, bf_hi(raw[e]) * qs);
            qf[ks] = __builtin_bit_cast(bf16x8, o);
        }
        const u32x4 r1 = *(const u32x4*)(qrow + 64), r2 = *(const u32x4*)(qrow + 80);
        const f32x4 c0 = *(const f32x4*)(cosm + sq * 16 + h * 8), c1 = *(const f32x4*)(cosm + sq * 16 + h * 8 + 4);
        const f32x4 s0 = *(const f32x4*)(sinm + sq * 16 + h * 8), s1 = *(const f32x4*)(sinm + sq * 16 + h * 8 + 4);
        float x1[8], x2[8], cc[8], ss[8], y1[8], y2[8];
#pragma unroll
        for (int e = 0; e < 4; ++e) { x1[2 * e] = bf_lo(r1[e]); x1[2 * e + 1] = bf_hi(r1[e]); x2[2 * e] = bf_lo(r2[e]); x2[2 * e + 1] = bf_hi(r2[e]);
            cc[e] = c0[e]; cc[4 + e] = c1[e]; ss[e] = s0[e]; ss[4 + e] = s1[e]; }
#pragma unroll
        for (int e = 0; e < 8; ++e) { y1[e] = (x1[e] * cc[e] - x2[e] * ss[e]) * qs; y2[e] = (x1[e] * ss[e] + x2[e] * cc[e]) * qs; }
        u32x4 o1, o2;
#pragma unroll
        for (int e = 0; e < 4; ++e) { o1[e] = pk_bf16(y1[2 * e], y1[2 * e + 1]); o2[e] = pk_bf16(y2[2 * e], y2[2 * e + 1]); }
        qf[4] = __builtin_bit_cast(bf16x8, o1); qf[5] = __builtin_bit_cast(bf16x8, o2);
    }
    constexpr int STG = 20480;
    const unsigned lds_u = (unsigned)(size_t)lds;
    const bf16_t* gA; const bf16_t* gB; const bf16_t* gC; int strideA, strideB;
    {
        const int c = tid, row = c / 12, cl = (c % 12) ^ ((row >> 2) & 3);
        if (cl < 8) { gA = KVb + row * 1024 + cl * 8; strideA = 64 * 1024; } else { gA = KRb + row * 32 + (cl - 8) * 8; strideA = 64 * 32; }
    }
    if (tid < 256) {
        const int c = 512 + tid, row = c / 12, cl = (c % 12) ^ ((row >> 2) & 3);
        if (cl < 8) { gB = KVb + row * 1024 + cl * 8; strideB = 64 * 1024; } else { gB = KRb + row * 32 + (cl - 8) * 8; strideB = 64 * 32; }
    } else {
        const int c = tid - 256, row = c >> 3, cl = (c & 7) ^ (((row >> 1) & 1) << 2);
        gB = KVb + row * 1024 + 64 + cl * 8; strideB = 64 * 1024;
    }
    {
        const int c = 256 + (tid & 255), row = c >> 3, cl = (c & 7) ^ (((row >> 1) & 1) << 2);
        gC = KVb + row * 1024 + 64 + cl * 8;
    }
    const bool lowhalf = __builtin_amdgcn_readfirstlane(wave) < 4;
    const unsigned dA = (unsigned)__builtin_amdgcn_readfirstlane(wave) * 1024u;
    const unsigned dB = lowhalf ? (512u * 16u + (unsigned)__builtin_amdgcn_readfirstlane(wave) * 1024u) : (12288u + (unsigned)(__builtin_amdgcn_readfirstlane(wave) - 4) * 1024u);
    const unsigned dC = 12288u + 256u * 16u + (unsigned)(__builtin_amdgcn_readfirstlane(wave) & 3) * 1024u;
#define MLA_DMA(TILE, HSLOT) do {                                                                                   \
        const unsigned sb_ = lds_u + (unsigned)(HSLOT) * (unsigned)STG;                                             \
        glds16(gA + (size_t)(TILE) * strideA, (unsigned)__builtin_amdgcn_readfirstlane(sb_ + dA));                  \
        glds16(gB + (size_t)(TILE) * strideB, (unsigned)__builtin_amdgcn_readfirstlane(sb_ + dB));                  \
        if (lowhalf) glds16(gC + (size_t)(TILE) * (64 * 1024), (unsigned)__builtin_amdgcn_readfirstlane(sb_ + dC)); \
    } while (0)
#pragma unroll
    for (int i = 0; i < 4; ++i) MLA_DMA(i, i);
    asm volatile("s_waitcnt vmcnt(0) lgkmcnt(0)\n\ts_barrier" ::: "memory");
    f32x16 o[2];
#pragma unroll
    for (int d = 0; d < 2; ++d)
#pragma unroll
        for (int i = 0; i < 16; ++i) o[d][i] = 0.f;
    float m = -1e30f, mb = 0.f, lsum = 0.f;
    f32x16 negm;
#pragma unroll
    for (int i = 0; i < 16; ++i) negm[i] = 0.f;
    const int q4 = (lane & 15) >> 2, p4 = lane & 3, blkk = (lane >> 4) & 1, xq = (q4 >> 1) & 1;
    int voff[2];
#pragma unroll
    for (int d = 0; d < 2; ++d) voff[d] = 12288 + (4 * h + q4) * 128 + ((4 * (d ^ xq) + 2 * blkk + (p4 >> 1)) << 4) + (p4 & 1) * 8;
    int koffs[6];
#pragma unroll
    for (int ks = 0; ks < 6; ++ks) koffs[ks] = l32 * 192 + (((2 * ks + h) ^ ((l32 >> 2) & 3)) << 4);
    int hs = 0;
    auto qk_first = [&](f32x16 (&sc)[2], ldsp kb_base) {
#pragma unroll
        for (int kb = 0; kb < 2; ++kb) {
            sc[kb] = MFMA(*(LAS bf16x8*)(kb_base + koffs[0] + kb * 6144), qf[0], negm);
#pragma unroll
            for (int ks = 1; ks < 6; ++ks) sc[kb] = MFMA(*(LAS bf16x8*)(kb_base + koffs[ks] + kb * 6144), qf[ks], sc[kb]);
        }
    };
    auto step = [&](f32x16 (&cur)[2], float bs, f32x16 (&nxt)[2], float& bsn, ldsp kb_base, ldsp vb_base) {
        float mx = cur[0][0];
#pragma unroll
        for (int i = 1; i < 16; ++i) mx = fmaxf(mx, cur[0][i]);
#pragma unroll
        for (int i = 0; i < 16; ++i) mx = fmaxf(mx, cur[1][i]);
        { auto rr = __builtin_amdgcn_permlane32_swap(__float_as_uint(mx), __float_as_uint(mx), false, false);
          mx = fmaxf(__uint_as_float(rr[0]), __uint_as_float(rr[1])); }
        const float cand = bs + mx;
        const float mnew = (cand > m + 8.0f) ? cand : m;
        const float dl = mnew - bs;
        if (__builtin_amdgcn_ballot_w64(dl != 0.f) != 0ull) {
#pragma unroll
            for (int kb = 0; kb < 2; ++kb)
#pragma unroll
                for (int i = 0; i < 16; ++i) cur[kb][i] -= dl;
        }
        if (__builtin_amdgcn_ballot_w64(mnew > m) != 0ull) {
            const float alpha = __builtin_amdgcn_exp2f(m - mnew);
#pragma unroll
            for (int d = 0; d < 2; ++d) o[d] = o[d] * alpha;
            lsum *= alpha; m = mnew; mb = mnew;
#pragma unroll
            for (int i = 0; i < 16; ++i) negm[i] = -mnew;
        }
        bsn = mb;
        bf16x8 kfa[6];
        s16x4 vlo[2][2], vhi[2][2];
#pragma unroll
        for (int ks = 0; ks < 6; ++ks) kfa[ks] = *(LAS bf16x8*)(kb_base + koffs[ks]);
#pragma unroll
        for (int s2 = 0; s2 < 2; ++s2)
#pragma unroll
            for (int d = 0; d < 2; ++d) {
                vlo[s2][d] = __builtin_amdgcn_ds_read_tr16_b64_v4i16((LAS s16x4*)(vb_base + voff[d] + (s2 * 16) * 128));
                vhi[s2][d] = __builtin_amdgcn_ds_read_tr16_b64_v4i16((LAS s16x4*)(vb_base + voff[d] + (s2 * 16 + 8) * 128));
            }
        bf16x8 kfb[6];
#pragma unroll
        for (int ks = 0; ks < 6; ++ks) kfb[ks] = *(LAS bf16x8*)(kb_base + koffs[ks] + 6144);
        SB();
        nxt[0] = MFMA(kfa[0], qf[0], negm);
#pragma unroll
        for (int ks = 1; ks < 6; ++ks) nxt[0] = MFMA(kfa[ks], qf[ks], nxt[0]);
#pragma unroll
        for (int i = 0; i < 16; ++i) { const float e = __builtin_amdgcn_exp2f(cur[0][i]); cur[0][i] = e; lsum += e; }
#pragma unroll
        for (int s2 = 0; s2 < 2; ++s2) {
            u32x4 pw;
#pragma unroll
            for (int e = 0; e < 4; ++e) pw[e] = pk_bf16(cur[0][8 * s2 + 2 * e], cur[0][8 * s2 + 2 * e + 1]);
            const bf16x8 pf = __builtin_bit_cast(bf16x8, pw);
#pragma unroll
            for (int d = 0; d < 2; ++d) o[d] = MFMA(__builtin_shufflevector(vlo[s2][d], vhi[s2][d], 0, 1, 2, 3, 4, 5, 6, 7), pf, o[d]);
        }
#pragma unroll
        for (int s2 = 0; s2 < 2; ++s2)
#pragma unroll
            for (int d = 0; d < 2; ++d) {
                vlo[s2][d] = __builtin_amdgcn_ds_read_tr16_b64_v4i16((LAS s16x4*)(vb_base + voff[d] + (32 + s2 * 16) * 128));
                vhi[s2][d] = __builtin_amdgcn_ds_read_tr16_b64_v4i16((LAS s16x4*)(vb_base + voff[d] + (32 + s2 * 16 + 8) * 128));
            }
        SB();
        nxt[1] = MFMA(kfb[0], qf[0], negm);
#pragma unroll
        for (int ks = 1; ks < 6; ++ks) nxt[1] = MFMA(kfb[ks], qf[ks], nxt[1]);
#pragma unroll
        for (int i = 0; i < 16; ++i) { const float e = __builtin_amdgcn_exp2f(cur[1][i]); cur[1][i] = e; lsum += e; }
#pragma unroll
        for (int s2 = 0; s2 < 2; ++s2) {
            u32x4 pw;
#pragma unroll
            for (int e = 0; e < 4; ++e) pw[e] = pk_bf16(cur[1][8 * s2 + 2 * e], cur[1][8 * s2 + 2 * e + 1]);
            const bf16x8 pf = __builtin_bit_cast(bf16x8, pw);
#pragma unroll
            for (int d = 0; d < 2; ++d) o[d] = MFMA(__builtin_shufflevector(vlo[s2][d], vhi[s2][d], 0, 1, 2, 3, 4, 5, 6, 7), pf, o[d]);
        }
    };
    f32x16 scA[2], scB[2];
    float bsA = mb, bsB = 0.f;
    qk_first(scA, lds);
#define MLA_STEP(CUR, BSCUR, NXT, BSNXT, TT, ODD) do {                                                              \
        const int t_ = (TT);                                                                                        \
        const int h1_ = (hs + 1 >= 6) ? hs + 1 - 6 : hs + 1, h4_ = (hs + 4 >= 6) ? hs + 4 - 6 : hs + 4;              \
        if (t_ + 4 < 128) MLA_DMA(t_ + 4, h4_);                                                                     \
        step(CUR, BSCUR, NXT, BSNXT, lds + h1_ * STG, lds + hs * STG);                                              \
        if (ODD) {                                                                                                  \
            if (t_ + 4 < 128) {                                                                                     \
                if (lowhalf) asm volatile("s_waitcnt vmcnt(3) lgkmcnt(0)\n\ts_barrier" ::: "memory");               \
                else asm volatile("s_waitcnt vmcnt(2) lgkmcnt(0)\n\ts_barrier" ::: "memory");                       \
            } else asm volatile("s_waitcnt vmcnt(0) lgkmcnt(0)\n\ts_barrier" ::: "memory");                         \
        }                                                                                                           \
        hs = h1_;                                                                                                   \
    } while (0)
    for (int kt = 0; kt < 128; kt += 2) {
        MLA_STEP(scA, bsA, scB, bsB, kt, false);
        MLA_STEP(scB, bsB, scA, bsA, kt + 1, true);
    }
#undef MLA_STEP
#undef MLA_DMA
    lsum += __shfl_xor(lsum, 32);
    const float inv = __builtin_amdgcn_rcpf(lsum);
    {
        const bf16_t* grow = P + (size_t)tq * INW + C_GA + head * 64;
        bf16_t* mrow = MIX + (size_t)tq * 1024 + head * 64;
#pragma unroll
        for (int d = 0; d < 2; ++d)
#pragma unroll
            for (int gq = 0; gq < 4; ++gq) {
                const int dd = d * 32 + 8 * gq + 4 * h;
                const u32x2 gt = *(const u32x2*)(grow + dd);
                u32x2 ov;
                ov[0] = pk_bf16(o[d][4 * gq] * inv * silu_f(bf_lo(gt[0])), o[d][4 * gq + 1] * inv * silu_f(bf_hi(gt[0])));
                ov[1] = pk_bf16(o[d][4 * gq + 2] * inv * silu_f(bf_lo(gt[1])), o[d][4 * gq + 3] * inv * silu_f(bf_hi(gt[1])));
                *(u32x2*)(mrow + dd) = ov;
            }
    }
    {
        const int tk = b * 8192 + qb * 256 + (tid >> 1), dh = (tid & 1) * 32;
        float l0 = LSE[((size_t)0 * T + tk) * 8 + head], l1 = LSE[((size_t)1 * T + tk) * 8 + head], l2 = LSE[((size_t)2 * T + tk) * 8 + head];
        const float lm = fmaxf(l0, fmaxf(l1, l2));
        float w0 = __builtin_amdgcn_exp2f(l0 - lm), w1 = __builtin_amdgcn_exp2f(l1 - lm), w2 = __builtin_amdgcn_exp2f(l2 - lm);
        const float wi = __builtin_amdgcn_rcpf(w0 + w1 + w2); w0 *= wi; w1 *= wi; w2 *= wi;
        const bf16_t* prow = P + (size_t)tk * INW;
        const bf16_t* o0 = prow + C_DQ + head * 64 + dh; const bf16_t* o1 = o0 + 1536; const bf16_t* o2 = o0 + 3072;
        const bf16_t* gb = prow + C_GB + head * 64 + dh;
        bf16_t* mrow = MIX + (size_t)tk * 1024 + 512 + head * 64 + dh;
#pragma unroll
        for (int c = 0; c < 4; ++c) {
            const u32x4 a0 = *(const u32x4*)(o0 + c * 8), a1 = *(const u32x4*)(o1 + c * 8), a2 = *(const u32x4*)(o2 + c * 8), gg = *(const u32x4*)(gb + c * 8);
            u32x4 ov;
#pragma unroll
            for (int e = 0; e < 4; ++e) {
                const float vlo = (w0 * bf_lo(a0[e]) + w1 * bf_lo(a1[e]) + w2 * bf_lo(a2[e])) * silu_f(bf_lo(gg[e]));
                const float vhi = (w0 * bf_hi(a0[e]) + w1 * bf_hi(a1[e]) + w2 * bf_hi(a2[e])) * silu_f(bf_hi(gg[e]));
                ov[e] = pk_bf16(vlo, vhi);
            }
            *(u32x4*)(mrow + c * 8) = ov;
        }
    }
}

__global__ void __launch_bounds__(512) hymba_fwd(Params p_arg) {
    extern __shared__ __attribute__((aligned(16))) unsigned char smem_raw[];
    __shared__ u32x4 xb_words;
    ldsp lds = (ldsp)smem_raw;
    if (threadIdx.x == 0) xb_words = (u32x4){0u, 0u, 0u, 0u};
    __syncthreads();
    XcdBarrier bar;
    { const Params& p = load_params(); bar = xcd_barrier_post((unsigned*)(p.ws + WS_BAR), (volatile LAS unsigned*)&xb_words); }
    { const Params& p = load_params(); prologue_phase(p, lds); }
    {
        const Params& p = load_params(); float* ssq = (float*)(p.ws + WS_SSQ);
        for (int i = bid_fresh() * 512 + tid_fresh(); i < (NLAYER - 1) * T; i += gridDim.x * 512) ssq[T + i] = 0.f;
        float* ssql = (float*)(p.ws + WS_SSQL);
        for (int i = bid_fresh() * 512 + tid_fresh(); i < NLAYER * 2 * T; i += gridDim.x * 512) ssql[i] = 0.f;
        norm_phase(p.x, (bf16_t*)(p.ws + WS_XB2), ssq);
    }
    cg::this_grid().sync();
    int vb, vc;
    {
        const Params& p = load_params(); unsigned* barw = (unsigned*)(p.ws + WS_BAR);
        bool ok = (gridDim.x == 256);
#pragma unroll
        for (unsigned j = 0; j < 16; ++j) { const unsigned c = xb_ld(&barw[XB_XCNT(j)]); ok = ok && (c == (j < 8 ? 32u : 0u)); }
        const unsigned rank = ((volatile LAS unsigned*)&xb_words)[2];
        vb = ok ? (int)(bar.x * 32u + rank) : (int)blockIdx.x;
        vb = __builtin_amdgcn_readfirstlane(vb);
        vc = ok ? (int)(rank * 8u + bar.x) : (int)blockIdx.x;
        vc = __builtin_amdgcn_readfirstlane(vc);
    }

    for (int l = 0; l < NLAYER; ++l) {
        {
            const Params& p = load_params(); unsigned char* ws = p.ws;
            const bf16_t* W = (const bf16_t*)(ws + WS_WIN) + (size_t)l * INWP * 1024;
            EpiRowScaleBf16 epi{(bf16_t*)(ws + WS_P), INW, (const float*)(ws + WS_RSTD), INW};
            pg8::StaticOrder so; so.init(T, INWP, (int)gridDim.x, vb_fresh(vc));
            pg8::Gemm g{(const bf16_t*)(ws + WS_XB2), W, T, INWP, 1024};
            EpiInproj e2{(bf16_t*)(ws + WS_P), (const float*)(ws + WS_SSQ) + (size_t)l * T, (bf16_t*)(ws + WS_CQ), (bf16_t*)(ws + WS_CKV),
                         (float*)(ws + WS_SSQL) + (size_t)(2 * l) * T, (float*)(ws + WS_SSQL) + (size_t)(2 * l + 1) * T, (bf16_t*)(ws + WS_KR),
                         (const float*)(ws + WS_COSM), (const float*)(ws + WS_SINM)};
            (void)epi;
            pg8::gemm_phase<EpiInproj, pg8::StaticOrder, true, true>(lds, g, so, e2);
            if (l + 1 < NLAYER) {
                const int id = vb_fresh(vc), G = (int)gridDim.x;
                if (G == 256) { if (id >= 64) convert_weights(p, lds, (l + 1) * TILES_PER_LAYER, (l + 2) * TILES_PER_LAYER, id - 64, 192); }
                else convert_weights(p, lds, (l + 1) * TILES_PER_LAYER, (l + 2) * TILES_PER_LAYER, id, G);
            }
        }
        xcd_barrier(bar);
        {
            const Params& p = load_params(); unsigned char* ws = p.ws;
            const bf16_t* Wq = (const bf16_t*)(ws + WS_WUQ) + (size_t)l * 768 * 384;
            const bf16_t* Wkv = (const bf16_t*)(ws + WS_WUKV) + (size_t)l * 1024 * 256;
            {
                pg8::StaticOrder so; so.init(T, 768, (int)gridDim.x, vb_fresh(vc));
                pg8::Gemm g{(const bf16_t*)(ws + WS_CQ), Wq, T, 768, 384};
                EpiUpRow eq{(bf16_t*)(ws + WS_Q), (const float*)(ws + WS_SSQL) + (size_t)(2 * l) * T, 768, 1.0f / 384.0f};
                pg8::gemm_phase<EpiUpRow, pg8::StaticOrder, false, true>(lds, g, so, eq);
            }
            {
                pg8::StaticOrder so; so.init(T, 1024, (int)gridDim.x, vb_fresh(vc));
                pg8::Gemm g{(const bf16_t*)(ws + WS_CKV), Wkv, T, 1024, 256};
                EpiUpRow ekv{(bf16_t*)(ws + WS_KF), (const float*)(ws + WS_SSQL) + (size_t)(2 * l + 1) * T, 1024, 1.0f / 256.0f};
                pg8::gemm_phase<EpiUpRow, pg8::StaticOrder, false, true>(lds, g, so, ekv);
            }
        }
        {
            const Params& p = load_params();
            for (int it = bid_fresh(); it < 1536; it += gridDim.x) dil_item(p, it, lds);
        }
        xcd_barrier(bar);
        {
            const Params& p = load_params();
            for (int it = vb_fresh(vb); it < 512; it += gridDim.x) mla_item(p, it >> 8, (it >> 5) & 7, it & 31, lds);
        }
        xcd_barrier(bar);
        {
            const Params& p = load_params(); unsigned char* ws = p.ws;
            const bf16_t* Wo = (const bf16_t*)(ws + WS_WOUT) + (size_t)l * 1024 * 1024;
            EpiResid eo{p.out, l == 0 ? p.x : (const float*)p.out};
            pg8::StaticOrder so; so.init(T, 1024, (int)gridDim.x, vb_fresh(vc));
            pg8::Gemm g{(const bf16_t*)(ws + WS_XB), Wo, T, 1024, 1024};
            EpiOutRes e2{p.out, l == 0 ? p.x : (const float*)p.out, (bf16_t*)(ws + WS_XB2), (l + 1 < NLAYER) ? (float*)(ws + WS_SSQ) + (size_t)(l + 1) * T : nullptr};
            (void)eo;
            pg8::gemm_phase<EpiOutRes, pg8::StaticOrder, false, true>(lds, g, so, e2);
        }
        xcd_barrier(bar);
    }
    { const Params& p = load_params(); final_phase(p.out, p.final_g); }
}

extern "C" void kernel_launch(void* const* d_in, const int* in_sizes, int n_in, void* d_out, int out_size, void* d_ws, size_t ws_size, hipStream_t stream) {
    static int grid_blocks = 0;
    if (!grid_blocks) {
        if (n_in != 9 || in_sizes[0] != T * DM || out_size != T * DM || ws_size < WS_END2) {
            fprintf(stderr, "kernel_launch: unexpected shapes (n_in %d, in0 %d, out %d, ws %zu need %zu)\n", n_in, n_in > 0 ? in_sizes[0] : -1, out_size, ws_size, (size_t)WS_END2);
            grid_blocks = -1; return;
        }
        int dev = 0, cus = 0, per_cu = 0;
        (void)hipGetDevice(&dev);
        (void)hipDeviceGetAttribute(&cus, hipDeviceAttributeMultiprocessorCount, dev);
        if (hipFuncSetAttribute((const void*)hymba_fwd, hipFuncAttributeMaxDynamicSharedMemorySize, LDS_BYTES) != hipSuccess) { fprintf(stderr, "kernel_launch: hipFuncSetAttribute failed\n"); grid_blocks = -1; return; }
        (void)hipOccupancyMaxActiveBlocksPerMultiprocessor(&per_cu, (const void*)hymba_fwd, 512, LDS_BYTES);
        if (per_cu < 1) { fprintf(stderr, "kernel_launch: occupancy query says 0 blocks per CU\n"); grid_blocks = -1; return; }
        grid_blocks = cus;
    }
    if (grid_blocks < 0) return;
    (void)hipMemsetAsync((unsigned char*)d_ws + WS_BAR, 0, 16384, stream);
    Params p{};
    p.x = (const float*)d_in[0]; p.norm_g = (const float*)d_in[1]; p.w_in = (const float*)d_in[2]; p.q_norm_g = (const float*)d_in[3];
    p.kv_norm_g = (const float*)d_in[4]; p.w_uq = (const float*)d_in[5]; p.w_ukv = (const float*)d_in[6]; p.w_out = (const float*)d_in[7];
    p.final_g = (const float*)d_in[8]; p.out = (float*)d_out; p.ws = (unsigned char*)d_ws;
    for (int i = 0; i < 16; ++i) { const float e = (2.0f * (float)i) / 32.0f; p.inv_m[i] = 1.0f / powf(500000.0f, e); }
    for (int i = 0; i < 8; ++i) { const float e = (2.0f * (float)i) / 16.0f; p.inv_d[i] = 1.0f / powf(500000.0f, e); }
    void* args[] = {&p};
    hipError_t e = hipLaunchCooperativeKernel((const void*)hymba_fwd, dim3(grid_blocks), dim3(512), args, LDS_BYTES, stream);
    if (e != hipSuccess) fprintf(stderr, "kernel_launch: cooperative launch failed: %s (grid %d)\n", hipGetErrorString(e), grid_blocks);
}
```
